# Optimizing an MI355X kernel written in HIP

```python
import math
import jax, jax.numpy as jnp
from jax import lax
import numpy as np

D_MODEL = 4096
BATCH = 1
SEQ = 8192
DEPTH = 1
DEC_BATCH = 128
DEC_SEQ = 4
PAST_LEN = 8192
PAGE_SIZE = 128

LRU_WIDTH = D_MODEL
LRU_BLOCKS = 16
LRU_BLOCK = LRU_WIDTH // LRU_BLOCKS
CONV_WIDTH = 4
LRU_C = 8.0
HEAD_DIM = 64
N_HEADS = D_MODEL // 128
N_KV_HEADS = N_HEADS // 4
GROUP = N_HEADS // N_KV_HEADS
ATTN_WIDTH = N_HEADS * HEAD_DIM
KV_WIDTH = N_KV_HEADS * HEAD_DIM
WINDOW = 128
IN_SPLITS = (LRU_WIDTH, LRU_WIDTH, ATTN_WIDTH, KV_WIDTH, KV_WIDTH, ATTN_WIDTH, D_MODEL, D_MODEL)
IN_WIDTH = 2 * LRU_WIDTH + 2 * ATTN_WIDTH + 2 * KV_WIDTH + 2 * D_MODEL
RMS_EPS = 1e-6
NEG_INF = -1e30

kernel_name = "hawk_swa_sink_parallel_gated_decoder_step"


def _rmsnorm(x, g):
    xf = x.astype(jnp.float32)
    y = xf * lax.rsqrt(jnp.mean(xf * xf, axis=-1, keepdims=True) + RMS_EPS)
    return (y * g.astype(jnp.float32)).astype(x.dtype)


def _causal_conv(xp, w, b):
    t = xp.shape[1] - (CONV_WIDTH - 1)
    out = b
    for tap in range(CONV_WIDTH):
        out = out + xp[:, tap:tap + t] * w[tap]
    return out


def _rg_lru(x, h0, w_a, b_a, w_x, b_x, lam):
    n, t, _ = x.shape
    xb = x.reshape(n, t, LRU_BLOCKS, LRU_BLOCK)
    gate_a = jax.nn.sigmoid(jnp.einsum('ntbi,bij->ntbj', xb, w_a.astype(jnp.float32)).reshape(n, t, LRU_WIDTH) + b_a.astype(jnp.float32))
    gate_x = jax.nn.sigmoid(jnp.einsum('ntbi,bij->ntbj', xb, w_x.astype(jnp.float32)).reshape(n, t, LRU_WIDTH) + b_x.astype(jnp.float32))
    log_a = -LRU_C * gate_a * jax.nn.softplus(-lam.astype(jnp.float32))
    a = jnp.exp(log_a)
    b = jnp.sqrt(-jnp.expm1(2.0 * log_a)) * (gate_x * x)
    b = b.at[:, 0].add(a[:, 0] * h0)

    def combine(left, right):
        a_l, b_l = left
        a_r, b_r = right
        return a_l * a_r, a_r * b_l + b_r

    _, h = lax.associative_scan(combine, (a, b), axis=1)
    return h, h[:, -1]


def _sink_attention(q, k, v, q_pos, k_pos, sinks):
    s = jnp.einsum('...qkgd,...skd->...kgqs', q.astype(jnp.float32), k.astype(jnp.float32)) * (HEAD_DIM ** -0.5)
    rel = q_pos[..., :, None] - k_pos[..., None, :]
    mask = (rel >= 0) & (rel <= WINDOW) & (k_pos[..., None, :] >= 0)
    s = jnp.where(mask[..., None, None, :, :], s, NEG_INF)
    sink = sinks.astype(jnp.float32).reshape(N_KV_HEADS, GROUP, 1, 1)
    m = jnp.maximum(jnp.max(s, axis=-1, keepdims=True), sink)
    p = jnp.exp(s - m)
    denom = jnp.sum(p, axis=-1, keepdims=True) + jnp.exp(sink - m)
    out = jnp.einsum('...kgqs,...skd->...qkgd', p / denom, v.astype(jnp.float32))
    return out.astype(v.dtype)


def _attn_prompt(q, k, v, sinks):
    n, t = q.shape[0], q.shape[1]
    nb = t // WINDOW
    qb = q.reshape(n, nb, WINDOW, N_KV_HEADS, GROUP, HEAD_DIM)
    kb = k.reshape(n, nb, WINDOW, N_KV_HEADS, HEAD_DIM)
    vb = v.reshape(n, nb, WINDOW, N_KV_HEADS, HEAD_DIM)
    kk = jnp.concatenate([jnp.concatenate([jnp.zeros_like(kb[:, :1]), kb[:, :-1]], axis=1), kb], axis=2)
    vv = jnp.concatenate([jnp.concatenate([jnp.zeros_like(vb[:, :1]), vb[:, :-1]], axis=1), vb], axis=2)
    pos = jnp.arange(t, dtype=jnp.int32).reshape(nb, WINDOW)
    k_pos = jnp.concatenate([pos - WINDOW, pos], axis=-1)
    o = _sink_attention(qb, kk, vv, pos, k_pos, sinks)
    return o.reshape(n, t, ATTN_WIDTH)


def _attn_sample(q, kk, vv, sinks, wb):
    n, t = q.shape[0], q.shape[1]
    qg = q.reshape(n, t, N_KV_HEADS, GROUP, HEAD_DIM)
    q_pos = PAST_LEN + jnp.arange(t, dtype=jnp.int32)
    k_pos = jnp.concatenate([PAST_LEN - wb + jnp.arange(wb, dtype=jnp.int32), q_pos])
    o = _sink_attention(qg, kk, vv, q_pos, k_pos, sinks)
    return o.reshape(n, t, ATTN_WIDTH)


def _mixer(xn, conv_buf, h0, k_buf, v_buf, w_in, conv_w, conv_b, lru_w_a, lru_b_a, lru_w_x, lru_b_x,
           lru_lambda, attn_sinks, w_branch, w_out, is_prompt):
    n, t, _ = xn.shape
    z = xn @ w_in
    offs = []
    acc = 0
    for wdt in IN_SPLITS[:-1]:
        acc += wdt
        offs.append(acc)
    x_lru, g_lru, q, k, v, g_attn, m_a, m_b = jnp.split(z, offs, axis=-1)
    xp = jnp.concatenate([conv_buf.astype(x_lru.dtype), x_lru], axis=1)
    new_conv = xp[:, -(CONV_WIDTH - 1):]
    xc = _causal_conv(xp, conv_w, conv_b)
    h, h_last = _rg_lru(xc.astype(jnp.float32), h0.astype(jnp.float32), lru_w_a, lru_b_a, lru_w_x, lru_b_x, lru_lambda)
    o_a = h.astype(xn.dtype) * jax.nn.silu(g_lru)
    q = q.reshape(n, t, N_HEADS, HEAD_DIM)
    k = k.reshape(n, t, N_KV_HEADS, HEAD_DIM)
    v = v.reshape(n, t, N_KV_HEADS, HEAD_DIM)
    if is_prompt:
        wb = min(WINDOW, t)
        o = _attn_prompt(q, k, v, attn_sinks)
        new_k, new_v = k[:, -wb:], v[:, -wb:]
    else:
        wb = k_buf.shape[1]
        kk = jnp.concatenate([k_buf.astype(k.dtype), k], axis=1)
        vv = jnp.concatenate([v_buf.astype(v.dtype), v], axis=1)
        o = _attn_sample(q, kk, vv, attn_sinks, wb)
        new_k, new_v = kk[:, -wb:], vv[:, -wb:]
    o_b = o * jax.nn.silu(g_attn)
    merged = (jax.nn.sigmoid(m_a) * (o_a @ w_branch[:LRU_WIDTH])
              + jax.nn.sigmoid(m_b) * (o_b @ w_branch[LRU_WIDTH:]))
    return merged @ w_out, new_conv, h_last, new_k, new_v


def setup_inputs(seed: int = 0) -> dict:
    key = jax.random.key(seed)
    ks = jax.random.split(key, 20)
    wb = min(WINDOW, PAST_LEN)
    f32 = jnp.float32
    u = jax.random.uniform(ks[12], (DEPTH, LRU_WIDTH), f32, 0.9, 0.999)
    s = u ** (1.0 / LRU_C)
    lam = jnp.log(s) - jnp.log1p(-s)
    return {
        "x_prompt": jax.random.normal(ks[0], (BATCH, SEQ, D_MODEL), f32),
        "x_sample": jax.random.normal(ks[1], (DEC_BATCH, DEC_SEQ, D_MODEL), f32),
        "state_conv": jax.random.normal(ks[2], (DEPTH, DEC_BATCH, CONV_WIDTH - 1, LRU_WIDTH), f32),
        "state_h": 0.5 * jax.random.normal(ks[3], (DEPTH, DEC_BATCH, LRU_WIDTH), f32),
        "cache_k_win": jax.random.normal(ks[4], (DEPTH, DEC_BATCH, wb, N_KV_HEADS, HEAD_DIM), f32),
        "cache_v_win": jax.random.normal(ks[5], (DEPTH, DEC_BATCH, wb, N_KV_HEADS, HEAD_DIM), f32),
        "norm_pre": 1.0 + 0.05 * jax.random.normal(ks[6], (DEPTH, D_MODEL), f32),
        "norm_post": 1.0 + 0.05 * jax.random.normal(ks[7], (DEPTH, D_MODEL), f32),
        "w_in": jax.random.normal(ks[8], (DEPTH, D_MODEL, IN_WIDTH), f32) * D_MODEL ** -0.5,
        "conv_w": jax.random.normal(ks[9], (DEPTH, CONV_WIDTH, LRU_WIDTH), f32) * CONV_WIDTH ** -0.5,
        "conv_b": 0.02 * jax.random.normal(ks[10], (DEPTH, LRU_WIDTH), f32),
        "lru_w_a": jax.random.normal(ks[11], (DEPTH, LRU_BLOCKS, LRU_BLOCK, LRU_BLOCK), f32) * LRU_BLOCK ** -0.5,
        "lru_b_a": 0.02 * jax.random.normal(ks[13], (DEPTH, LRU_WIDTH), f32),
        "lru_w_x": jax.random.normal(ks[14], (DEPTH, LRU_BLOCKS, LRU_BLOCK, LRU_BLOCK), f32) * LRU_BLOCK ** -0.5,
        "lru_b_x": 0.02 * jax.random.normal(ks[15], (DEPTH, LRU_WIDTH), f32),
        "lru_lambda": lam,
        "attn_sinks": 0.5 * jax.random.normal(ks[16], (DEPTH, N_HEADS), f32),
        "w_branch": jax.random.normal(ks[17], (DEPTH, LRU_WIDTH + ATTN_WIDTH, D_MODEL), f32) * D_MODEL ** -0.5,
        "w_out": jax.random.normal(ks[18], (DEPTH, D_MODEL, D_MODEL), f32) * D_MODEL ** -0.5,
    }


def reference(x_prompt, x_sample, state_conv, state_h, cache_k_win, cache_v_win, norm_pre, norm_post,
              w_in, conv_w, conv_b, lru_w_a, lru_b_a, lru_w_x, lru_b_x, lru_lambda, attn_sinks,
              w_branch, w_out):
    xp_res, xs_res = x_prompt, x_sample
    pc, ph, pk, pv = [], [], [], []
    sc, sh, sk, sv = [], [], [], []
    for l in range(DEPTH):
        lw = (w_in[l], conv_w[l], conv_b[l], lru_w_a[l], lru_b_a[l], lru_w_x[l], lru_b_x[l],
              lru_lambda[l], attn_sinks[l], w_branch[l], w_out[l])
        xn = _rmsnorm(xp_res, norm_pre[l])
        zero_conv = jnp.zeros((xp_res.shape[0], CONV_WIDTH - 1, LRU_WIDTH), xp_res.dtype)
        zero_h = jnp.zeros((xp_res.shape[0], LRU_WIDTH), jnp.float32)
        o, c_new, h_new, k_new, v_new = _mixer(xn, zero_conv, zero_h, None, None, *lw, True)
        xp_res = xp_res + _rmsnorm(o, norm_post[l])
        pc.append(c_new)
        ph.append(h_new.astype(state_h.dtype))
        pk.append(k_new)
        pv.append(v_new)
        xn = _rmsnorm(xs_res, norm_pre[l])
        o, c_new, h_new, k_new, v_new = _mixer(xn, state_conv[l], state_h[l], cache_k_win[l], cache_v_win[l], *lw, False)
        xs_res = xs_res + _rmsnorm(o, norm_post[l])
        sc.append(c_new)
        sh.append(h_new.astype(state_h.dtype))
        sk.append(k_new)
        sv.append(v_new)
    return (xp_res, xs_res,
            jnp.stack(pc), jnp.stack(ph), jnp.stack(pk), jnp.stack(pv),
            jnp.stack(sc), jnp.stack(sh), jnp.stack(sk), jnp.stack(sv))
```

```cpp
#include <hip/hip_runtime.h>
#include <cstdio>
#include <cstdint>

#ifndef MK_N_LAUNCHES
#define MK_N_LAUNCHES 1
#endif
constexpr int N_LAUNCHES = MK_N_LAUNCHES;
#ifndef DUP_PHASE
#define DUP_PHASE -1
#endif
#define REPS(k) for (int rep_ = 0; rep_ < ((DUP_PHASE) == (k) ? 2 : 1); ++rep_)
constexpr int N_PHASES = 5;

#define LAS __attribute__((address_space(3)))
#define GAS __attribute__((address_space(1)))
typedef unsigned short bf16_t;
typedef short bf16x8 __attribute__((ext_vector_type(8)));
typedef float f32x4 __attribute__((ext_vector_type(4)));
typedef float f32x16 __attribute__((ext_vector_type(16)));
typedef unsigned u32x4 __attribute__((ext_vector_type(4)));
typedef unsigned u32x2 __attribute__((ext_vector_type(2)));
typedef float f32x2_t __attribute__((ext_vector_type(2)));
typedef __bf16 bf16x2_t __attribute__((ext_vector_type(2)));

constexpr int DM = 4096, SEQ = 8192, DECB = 128, DECT = 4, MROWS = SEQ + DECB * DECT;
constexpr int NBLK = 16, BLK = 256;
constexpr int HD = 64, NH = 32, NKV = 8, AW = NH * HD, KVW = NKV * HD, WIN = 128;
constexpr int INW = 2 * DM + 2 * AW + 2 * KVW + 2 * DM;
constexpr int KBR = DM + AW;
constexpr float RMS_EPS = 1e-6f;
constexpr float LOG2E = 1.4426950408889634f;
constexpr float QSCALE = 0.125f * LOG2E;
static_assert(INW == 21504 && MROWS == 8704, "shapes");
constexpr size_t O_YP = 0, O_YS = (size_t)SEQ * DM, O_CP = O_YS + (size_t)DECB * DECT * DM, O_HP = O_CP + 3 * DM, O_KP = O_HP + DM, O_VP = O_KP + (size_t)WIN * KVW,
                 O_CS = O_VP + (size_t)WIN * KVW, O_HS = O_CS + (size_t)DECB * 3 * DM, O_KS = O_HS + (size_t)DECB * DM, O_VS = O_KS + (size_t)DECB * WIN * KVW, O_END = O_VS + (size_t)DECB * WIN * KVW;
static_assert(O_END == 54673408, "output size");

constexpr size_t MiB = 1u << 20;
constexpr size_t WS_CTL = 0, CTL_ZERO_BYTES = 1 * MiB;
constexpr size_t WS_WIN = 1 * MiB;
constexpr size_t WS_WBR = 169 * MiB;
constexpr size_t WS_WOUT = 217 * MiB;
constexpr size_t WS_WG = 249 * MiB;
constexpr size_t WS_XN = 253 * MiB;
constexpr size_t WS_XL = 321 * MiB, WS_GL = 389 * MiB;
constexpr size_t WS_Q = 457 * MiB;
constexpr size_t WS_K = 491 * MiB, WS_V = 500 * MiB;
constexpr size_t WS_GA = 509 * MiB;
constexpr size_t WS_MA = 543 * MiB, WS_MB = 611 * MiB;
constexpr size_t WS_HLOC = 679 * MiB, WS_ACUM = 747 * MiB;
constexpr size_t WS_OAB = 815 * MiB;
constexpr size_t WS_CARA = 917 * MiB, WS_CARH = 919 * MiB;
constexpr size_t WS_PSS = 921 * MiB;
constexpr size_t WS_VCT = 925 * MiB;
constexpr size_t WS_KC = 942 * MiB;
constexpr size_t WS_LC = 959 * MiB;
constexpr size_t WS_OF1 = 960 * MiB;
constexpr size_t WS_END = 976 * MiB;
static_assert(WS_WIN + (size_t)INW * DM * 2 <= WS_WBR && WS_WBR + (size_t)DM * KBR * 2 <= WS_WOUT && WS_WOUT + (size_t)DM * DM * 2 <= WS_WG && WS_XN + (size_t)MROWS * DM * 2 <= WS_XL, "ws map");
static_assert(WS_HLOC + (size_t)MROWS * DM * 4 <= WS_OAB && WS_OAB + (size_t)MROWS * KBR * 2 <= WS_CARA && WS_K + (size_t)MROWS * KVW * 2 <= WS_V && WS_V + (size_t)MROWS * KVW * 2 <= WS_GA, "ws map");
constexpr int CW_BAR = 4096;
constexpr int CW_TMO = 64;
constexpr int CW_BD = 8192, CW_OD = CW_BD + 64 * 64, CW_FQ = CW_OD + 64 * 64;
constexpr int CW_Q1 = CW_FQ + 64, CW_Q2 = CW_Q1 + 64;
constexpr int NPAN = MROWS / 256, NCT = DM / 256;

constexpr int RING_BYTES = 131072, LDSCTL_OFF = RING_BYTES, MISC_OFF = LDSCTL_OFF + 320, LDS_BYTES = 147456;
constexpr int NWAVES = 8;

__device__ __forceinline__ float bf2f(unsigned b) { return __uint_as_float(b << 16); }
__device__ __forceinline__ float bflo(unsigned w) { return __uint_as_float(w << 16); }
__device__ __forceinline__ float bfhi(unsigned w) { return __uint_as_float(w & 0xffff0000u); }
__device__ __forceinline__ unsigned cvtpk(float lo, float hi) { f32x2_t v = {lo, hi}; bf16x2_t b = __builtin_convertvector(v, bf16x2_t); return __builtin_bit_cast(unsigned, b); }
__device__ __forceinline__ float sigmoidf_(float v) { return __builtin_amdgcn_rcpf(1.0f + __builtin_amdgcn_exp2f(-v * LOG2E)); }
__device__ __forceinline__ float wave_sum(float v) {
#pragma unroll
    for (int o = 1; o < 64; o <<= 1) v += __shfl_xor(v, o);
    return v;
}
#define LDS_WAIT() asm volatile("s_waitcnt lgkmcnt(0)" ::: "memory")
#define VM_WAIT() asm volatile("s_waitcnt vmcnt(0)" ::: "memory")

namespace gm {
constexpr int BM = 256, BK = 64, HALF = 128, HTB = HALF * BK * 2, STAGE_BYTES = 8 * HTB, NXCD = 8, WGM = 8;
__host__ __device__ __forceinline__ int lds_byte(int r, int c) { const int st = (r >> 4) * 2 + (c >> 5), rr = r & 15, cc = c & 31, ob = rr * 64 + cc * 2; return st * 1024 + (ob ^ (((ob >> 9) & 1) << 5)); }
__host__ __device__ __forceinline__ void stage_rc(int b, int& R, int& C) { const int st = b / 1024, sb = b % 1024, swz = sb ^ (((sb >> 9) & 1) << 5); R = (st >> 1) * 16 + swz / 64; C = (st & 1) * 32 + (swz % 64) / 2; }
__host__ __device__ __forceinline__ int perm32(int rho) { const int n = rho >> 4, i = rho & 15; return 8 * (i >> 2) + 4 * n + (i & 3); }

struct Unit { const char* A; const char* B; int nt; int pm, pn, part; };

__device__ __forceinline__ void tile_of(int L, int nM, int nN, int& pm, int& pn) {
    const int nwg = nM * nN; int wgid = L;
    { const int q = nwg / NXCD, r = nwg % NXCD, xcd = wgid % NXCD, off = wgid / NXCD; wgid = (xcd < r ? xcd * (q + 1) : r * (q + 1) + (xcd - r) * q) + off; }
    const int nig = WGM * nN, gid = wgid / nig, fm = gid * WGM, gsz = (nM - fm) < WGM ? (nM - fm) : WGM;
    pm = fm + ((wgid % nig) % gsz); pn = (wgid % nig) / gsz;
}

template <bool PERM, class Epi, class Sched>
__device__ __forceinline__ void gemm_phase(LAS unsigned char* lds, const int lda, const int ldb, const Sched& S, const Epi& E) {
    const int tid = threadIdx.x, wid = __builtin_amdgcn_readfirstlane(tid >> 6), lane = tid & 63, wr = wid >> 2, wc = wid & 3, fr = lane & 15, fq = lane >> 4;
    unsigned voffA[2], voffB[2];
#pragma unroll
    for (int i = 0; i < 2; ++i) { int R, C; stage_rc(tid * 16 + i * 8192, R, C); const int Rb = PERM ? ((R & ~31) + perm32(R & 31)) : R;
        voffA[i] = (unsigned)(R * lda + C) * 2u; voffB[i] = (unsigned)(Rb * ldb + C) * 2u; }
    const size_t kstep = (size_t)(BK * 2);
    const size_t hstepA = (size_t)HALF * lda * 2, hstepB = (size_t)HALF * ldb * 2;
    const unsigned ldsw = (unsigned)wid * 1024u;
    const int aoff = lds_byte(wr * 64 + fr, fq * 8), boff = lds_byte(wc * 32 + fr, fq * 8);
#define PG8_SA(b, h) (((b) * 2 + (h)) * HTB)
#define PG8_SB(b, h) ((4 + (b) * 2 + (h)) * HTB)
#define PG8_STAGE(bufoff, gbase, voff) do { _Pragma("unroll") for (int _i = 0; _i < 2; ++_i) \
        __builtin_amdgcn_global_load_lds((const unsigned*)((const char*)(gbase) + (voff)[_i]), (LAS unsigned*)(lds + (bufoff) + ldsw + _i * 8192), 16, 0, 0); } while (0)
#define PG8_LDA(dst, b, h) do { _Pragma("unroll") for (int m = 0; m < 4; ++m) _Pragma("unroll") for (int k = 0; k < 2; ++k) dst[m][k] = *(const LAS bf16x8*)(lds + PG8_SA(b, h) + aoff + m * 2048 + k * 1024); } while (0)
#define PG8_LDB(dst, b, h) do { _Pragma("unroll") for (int n = 0; n < 2; ++n) _Pragma("unroll") for (int k = 0; k < 2; ++k) dst[n][k] = *(const LAS bf16x8*)(lds + PG8_SB(b, h) + boff + n * 2048 + k * 1024); } while (0)
#define PG8_MMA(ai, bj, At, Bt) do { __builtin_amdgcn_s_setprio(1); _Pragma("unroll") for (int m = 0; m < 4; ++m) _Pragma("unroll") for (int n = 0; n < 2; ++n) _Pragma("unroll") for (int k = 0; k < 2; ++k) \
        acc[ai][bj][m][n] = __builtin_amdgcn_mfma_f32_16x16x32_bf16(Bt[n][k], At[m][k], acc[ai][bj][m][n], 0, 0, 0); __builtin_amdgcn_s_setprio(0); } while (0)
#define PG8_WAIT_V(n) asm volatile("s_waitcnt vmcnt(" #n ")" ::: "memory")
#define PG8_WAIT_L(n) asm volatile("s_waitcnt lgkmcnt(" #n ")" ::: "memory")
#define PG8_BAR __builtin_amdgcn_s_barrier()
#define PG8_SCHED __builtin_amdgcn_sched_barrier(0)
    Unit cur, nxt; int ui = 0;
    if (!S.next(0, cur)) return;
    f32x4 acc[2][2][4][2];
#pragma unroll
    for (int a = 0; a < 2; ++a)
#pragma unroll
        for (int b = 0; b < 2; ++b)
#pragma unroll
            for (int m = 0; m < 4; ++m)
#pragma unroll
                for (int n = 0; n < 2; ++n) acc[a][b][m][n] = (f32x4){0.f, 0.f, 0.f, 0.f};
    bf16x8 At[4][2], B0[2][2], B1[2][2];
    const char* cA = cur.A; const char* cB = cur.B;
    S.a_ready(cur);
    PG8_STAGE(PG8_SB(0, 0), cB, voffB); PG8_STAGE(PG8_SB(0, 1), cB + hstepB, voffB); PG8_STAGE(PG8_SA(0, 0), cA, voffA); PG8_STAGE(PG8_SA(0, 1), cA + hstepA, voffA);
    if (wr == 1) PG8_BAR;
    PG8_WAIT_V(2); PG8_BAR;
    PG8_STAGE(PG8_SB(1, 0), cB + kstep, voffB); PG8_STAGE(PG8_SA(1, 0), cA + kstep, voffA); PG8_STAGE(PG8_SB(1, 1), cB + hstepB + kstep, voffB);
    PG8_WAIT_V(6); PG8_BAR;
    for (;;) {
        const bool has_next = S.next(ui + 1, nxt);
        const char* nA = has_next ? nxt.A : cA; const char* nB = has_next ? nxt.B : cB;
        const int nt = cur.nt;
        for (int t = 0; t < nt; t += 2) {
            const bool last = (t == nt - 2);
            const char* a1 = cA + (size_t)(t + 1) * kstep;
            const char* a2 = last ? nA : cA + (size_t)(t + 2) * kstep; const char* b2 = last ? nB : cB + (size_t)(t + 2) * kstep;
            const char* a3 = a2 + kstep; const char* b3 = b2 + kstep;
            if (last && has_next) S.a_ready(nxt);
            PG8_LDB(B0, 0, 0); PG8_LDB(B1, 0, 1); PG8_SCHED; PG8_LDA(At, 0, 0); PG8_STAGE(PG8_SA(1, 1), a1 + hstepA, voffA);
            PG8_WAIT_V(8); PG8_WAIT_L(0); PG8_BAR; PG8_MMA(0, 0, At, B0); PG8_MMA(0, 1, At, B1); PG8_BAR; PG8_SCHED;
            PG8_LDA(At, 0, 1); PG8_STAGE(PG8_SB(0, 0), b2, voffB); PG8_STAGE(PG8_SB(0, 1), b2 + hstepB, voffB); PG8_STAGE(PG8_SA(0, 0), a2, voffA);
            PG8_WAIT_V(8); PG8_WAIT_L(0); PG8_BAR; PG8_MMA(1, 0, At, B0); PG8_MMA(1, 1, At, B1); PG8_BAR; PG8_SCHED;
            PG8_LDB(B0, 1, 0); PG8_LDB(B1, 1, 1); PG8_SCHED; PG8_LDA(At, 1, 0); PG8_STAGE(PG8_SA(0, 1), a2 + hstepA, voffA);
            PG8_WAIT_V(8); PG8_WAIT_L(0); PG8_BAR; PG8_MMA(0, 0, At, B0); PG8_MMA(0, 1, At, B1); PG8_BAR; PG8_SCHED;
            PG8_LDA(At, 1, 1); PG8_STAGE(PG8_SB(1, 0), b3, voffB); PG8_STAGE(PG8_SB(1, 1), b3 + hstepB, voffB); PG8_STAGE(PG8_SA(1, 0), a3, voffA);
            PG8_WAIT_V(8); PG8_WAIT_L(0); PG8_BAR; PG8_MMA(1, 0, At, B0); PG8_MMA(1, 1, At, B1); PG8_BAR; PG8_SCHED;
        }
        if (wr == 0) PG8_BAR;
        const bool keep = E(acc, cur, wr, wc, fr, fq);
        if (!has_next) break;
        if (!keep) {
#pragma unroll
            for (int a = 0; a < 2; ++a)
#pragma unroll
                for (int b = 0; b < 2; ++b)
#pragma unroll
                    for (int m = 0; m < 4; ++m)
#pragma unroll
                        for (int n = 0; n < 2; ++n) acc[a][b][m][n] = (f32x4){0.f, 0.f, 0.f, 0.f};
        }
        cur = nxt; cA = nA; cB = nB; ++ui;
        if (wr == 1) PG8_BAR;
    }
    PG8_WAIT_V(0);
    PG8_BAR;
#undef PG8_SA
#undef PG8_SB
#undef PG8_STAGE
#undef PG8_LDA
#undef PG8_LDB
#undef PG8_MMA
#undef PG8_WAIT_V
#undef PG8_WAIT_L
#undef PG8_BAR
#undef PG8_SCHED
}
}

#define XB_TMO      128
#define XB_XCNT(j)  (256  + 64 * (j))
#define XB_XSUB(j)  (1280 + 64 * (j))
#define XB_XGEN(j)  (2304 + 64 * (j))
#define XB_TOP      3328
#define XB_TOPGEN   3392
#define XCD_BAR_WORDS 3456
#define XB_SPIN_CAP (1u << 20)
__device__ __forceinline__ unsigned xb_ld(unsigned* p)              { return __hip_atomic_load(p, __ATOMIC_RELAXED, __HIP_MEMORY_SCOPE_AGENT); }
__device__ __forceinline__ unsigned xb_add(unsigned* p, unsigned v) { return __hip_atomic_fetch_add(p, v, __ATOMIC_RELAXED, __HIP_MEMORY_SCOPE_AGENT); }
__device__ __forceinline__ unsigned xb_xcc_id() { return (unsigned)__builtin_amdgcn_s_getreg((3 << 11) | 20) & 0xFu; }
#define XB_SPIN(cond, bar) do { unsigned _sp = 0; while (cond) { __builtin_amdgcn_s_sleep(1); \
    if ((++_sp & 255u) == 0u) { if (xb_ld(&(bar)[XB_TMO])) break; if (_sp > XB_SPIN_CAP) { atomicAdd(&(bar)[XB_TMO], 1u); break; } } } } while (0)
struct XcdBarrier { unsigned* bar; unsigned x; volatile LAS unsigned* st; };
__device__ __forceinline__ XcdBarrier xcd_barrier_post(unsigned* bar, volatile LAS unsigned* st) {
    XcdBarrier b; b.bar = bar; b.x = xb_xcc_id(); b.st = st;
    if (threadIdx.x == 0) (void)xb_add(&bar[XB_XCNT(b.x)], 1u);
    return b;
}
__device__ __forceinline__ void xcd_barrier_complete(unsigned* bar, unsigned x, unsigned& nloc, unsigned& nx) {
    const unsigned G = gridDim.x * gridDim.y * gridDim.z;
    unsigned sum, cnt, mine, sp = 0u;
    for (;;) {
        sum = 0u; cnt = 0u; mine = 0u;
#pragma unroll
        for (unsigned j = 0; j < 16; ++j) { const unsigned c = xb_ld(&bar[XB_XCNT(j)]); sum += c; cnt += (c > 0u) ? 1u : 0u; mine = (j == x) ? c : mine; }
        if (sum == G) break;
        __builtin_amdgcn_s_sleep(1);
        if ((++sp & 255u) == 0u) { if (xb_ld(&bar[XB_TMO])) break; if (sp > XB_SPIN_CAP) { atomicAdd(&bar[XB_TMO], 1u); break; } }
    }
    nloc = mine > 0u ? mine : 1u; nx = cnt > 0u ? cnt : 1u;
}
__device__ __forceinline__ void xcd_barrier(const XcdBarrier& b) {
    asm volatile("s_waitcnt vmcnt(0)" ::: "memory");
    __syncthreads();
    if (threadIdx.x == 0) {
        unsigned* bar = b.bar;
        __builtin_amdgcn_s_waitcnt(0);
        unsigned nloc = b.st[0], nx = b.st[1];
        if (nloc == 0u) { xcd_barrier_complete(bar, b.x, nloc, nx); b.st[0] = nloc; b.st[1] = nx; }
        const unsigned old = xb_add(&bar[XB_XSUB(b.x)], 1u);
        const unsigned gen = old / nloc;
        if (old + 1u == (gen + 1u) * nloc) {
            __builtin_amdgcn_fence(__ATOMIC_RELEASE, "agent");
            asm volatile("s_waitcnt vmcnt(0)" ::: "memory");
            const unsigned og = xb_add(&bar[XB_TOP], 1u);
            const unsigned tg = og / nx;
            if (og + 1u == (tg + 1u) * nx) xb_add(&bar[XB_TOPGEN], 1u);
            else XB_SPIN(xb_ld(&bar[XB_TOPGEN]) == tg, bar);
            __builtin_amdgcn_fence(__ATOMIC_ACQUIRE, "agent");
            xb_add(&bar[XB_XGEN(b.x)], 1u);
            asm volatile("s_waitcnt vmcnt(0)" ::: "memory");
        } else {
            XB_SPIN(xb_ld(&bar[XB_XGEN(b.x)]) == gen, bar);
            __builtin_amdgcn_fence(__ATOMIC_ACQUIRE, "agent");
            asm volatile("s_waitcnt vmcnt(0)" ::: "memory");
        }
    }
    __syncthreads();
}

struct Args { const float* in[19]; float* out; unsigned char* ws; int ph_lo, ph_hi; };
enum { I_XP = 0, I_XS, I_SCONV, I_SH, I_CK, I_CV, I_NPRE, I_NPOST, I_WIN, I_CONVW, I_CONVB, I_WA, I_BA, I_WX, I_BX, I_LAM, I_SINK, I_WBR, I_WOUT };

struct Frame {
    LAS unsigned char* lds;
    int tid, lane, wave, vcu, G;
};

__device__ __forceinline__ void p0_transpose_item(const float* W, int K, int N, bf16_t* WT, LAS float* scr, int item, int lane) {
    const int nblk = N / 32, kb = item / nblk, nb = item % nblk, k0 = 64 * kb, n0 = 32 * nb;
#pragma unroll 8
    for (int i = 0; i < 32; ++i) { const int kk = 2 * i + (lane >> 5); scr[kk * 33 + (lane & 31)] = W[(size_t)(k0 + kk) * N + n0 + (lane & 31)]; }
    LDS_WAIT(); asm volatile("" ::: "memory");
    const int c = lane & 7;
#pragma unroll
    for (int j = 0; j < 4; ++j) { const int n = (lane >> 3) + 8 * j; const LAS float* s = scr + (8 * c) * 33 + n;
        u32x4 o; o.x = cvtpk(s[0 * 33], s[1 * 33]); o.y = cvtpk(s[2 * 33], s[3 * 33]); o.z = cvtpk(s[4 * 33], s[5 * 33]); o.w = cvtpk(s[6 * 33], s[7 * 33]);
        *(GAS u32x4*)(WT + (size_t)(n0 + n) * K + k0 + 8 * c) = o; }
    LDS_WAIT(); asm volatile("" ::: "memory");
}

__device__ __forceinline__ void p0_prologue(const Frame& F, const Args& a) {
    unsigned char* ws = a.ws;
    LAS float* scr = (LAS float*)(F.lds + F.wave * 16384);
    const int gw = F.vcu * NWAVES + F.wave, NGW = F.G * NWAVES;
    constexpr int I_IN = (DM / 64) * (INW / 32), I_G = NBLK * (BLK / 64) * (BLK / 32);
    for (int it = gw; it < I_IN + 2 * I_G; it += NGW) {
        int r = it;
        if (r < I_IN) { p0_transpose_item(a.in[I_WIN], DM, INW, (bf16_t*)(ws + WS_WIN), scr, r, F.lane); continue; } r -= I_IN;
        const int gate = r >= I_G; if (gate) r -= I_G;
        const int blk = r / ((BLK / 64) * (BLK / 32)), sub = r % ((BLK / 64) * (BLK / 32));
        p0_transpose_item(a.in[gate ? I_WX : I_WA] + (size_t)blk * BLK * BLK, BLK, BLK, (bf16_t*)(ws + WS_WG) + (size_t)(blk * 2 + gate) * BLK * BLK, scr, sub, F.lane);
    }
    for (int ch = gw * 64 + F.lane; ch < DM; ch += NGW * 64) {
        float* lc = (float*)(ws + WS_LC);
        lc[ch] = -a.in[I_BA][ch] * LOG2E; lc[DM + ch] = -a.in[I_BX][ch] * LOG2E; lc[2 * DM + ch] = -8.0f * LOG2E * log1pf(expf(-a.in[I_LAM][ch]));
    }
    {
        const GAS f32x4* gp = (const GAS f32x4*)a.in[I_NPRE] + F.lane;
        bf16_t* XN = (bf16_t*)(ws + WS_XN);
        for (int m = gw; m < MROWS; m += NGW) {
            const float* xrow = (m < SEQ) ? a.in[I_XP] + (size_t)m * DM : a.in[I_XS] + (size_t)(m - SEQ) * DM;
            const GAS f32x4* xr = (const GAS f32x4*)xrow + F.lane;
            f32x4 v[16]; float s = 0.f;
#pragma unroll
            for (int j = 0; j < 16; ++j) { v[j] = xr[64 * j]; s += (v[j].x * v[j].x + v[j].y * v[j].y) + (v[j].z * v[j].z + v[j].w * v[j].w); }
            const float sc = 1.0f / sqrtf(wave_sum(s) * (1.0f / DM) + RMS_EPS);
            GAS u32x2* o8 = (GAS u32x2*)(XN + (size_t)m * DM) + F.lane;
#pragma unroll
            for (int j = 0; j < 16; ++j) { const f32x4 g = gp[64 * j]; u32x2 o; o.x = cvtpk(v[j].x * sc * g.x, v[j].y * sc * g.y); o.y = cvtpk(v[j].z * sc * g.z, v[j].w * sc * g.w); o8[64 * j] = o; }
        }
    }
}
constexpr int SD_T = ((KBR / 64) * (DM / 32) + (DM / 64) * (DM / 32) + DECB * (WIN / 64) * (KVW / 32)) / 64, SD_K = DECB * 4 / NWAVES, SD_S = 2 * DECB * 4 / NWAVES, SD_N = SD_T + SD_K + SD_S;
__device__ __forceinline__ void p0b_chunk(const Frame& F, const Args& a, int ch) {
    unsigned char* ws = a.ws;
    if (ch < SD_T) {
        LAS float* scr = (LAS float*)(F.lds + F.wave * 16384);
        constexpr int I_BR = (KBR / 64) * (DM / 32), I_OUT = (DM / 64) * (DM / 32);
#pragma unroll 1
        for (int k = 0; k < 8; ++k) {
            int r = ch * 64 + k * NWAVES + F.wave;
            if (r < I_BR) { p0_transpose_item(a.in[I_WBR], KBR, DM, (bf16_t*)(ws + WS_WBR), scr, r, F.lane); continue; } r -= I_BR;
            if (r < I_OUT) { p0_transpose_item(a.in[I_WOUT], DM, DM, (bf16_t*)(ws + WS_WOUT), scr, r, F.lane); continue; } r -= I_OUT;
            const int b = r / ((WIN / 64) * (KVW / 32)), sub = r % ((WIN / 64) * (KVW / 32));
            p0_transpose_item(a.in[I_CV] + (size_t)b * WIN * KVW, WIN, KVW, (bf16_t*)(ws + WS_VCT) + (size_t)b * WIN * KVW, scr, sub, F.lane);
        }
        return;
    }
    ch -= SD_T;
    if (ch < SD_K) {
        const int it = ch * NWAVES + F.wave;
        const GAS f32x4* src = (const GAS f32x4*)(a.in[I_CK] + (size_t)it * 32 * KVW) + F.lane;
        GAS u32x2* dst = (GAS u32x2*)((bf16_t*)(ws + WS_KC) + (size_t)it * 32 * KVW) + F.lane;
#pragma unroll 1
        for (int i0 = 0; i0 < 64; i0 += 8) { f32x4 v[8];
#pragma unroll
            for (int i = 0; i < 8; ++i) v[i] = src[64 * (i0 + i)];
#pragma unroll
            for (int i = 0; i < 8; ++i) { u32x2 o; o.x = cvtpk(v[i].x, v[i].y); o.y = cvtpk(v[i].z, v[i].w); dst[64 * (i0 + i)] = o; } }
        return;
    }
    ch -= SD_K;
    {
        const int it = ch * NWAVES + F.wave, kv = it / (DECB * 4), b = (it / 4) % DECB, qd = it % 4;
        const GAS f32x4* src = (const GAS f32x4*)(a.in[kv ? I_CV : I_CK] + (size_t)b * WIN * KVW + (size_t)(4 + 31 * qd) * KVW) + F.lane;
        GAS f32x4* dst = (GAS f32x4*)(a.out + (kv ? O_VS : O_KS) + (size_t)b * WIN * KVW + (size_t)(31 * qd) * KVW) + F.lane;
#pragma unroll 1
        for (int i0 = 0; i0 < 56; i0 += 8) { f32x4 v[8];
#pragma unroll
            for (int i = 0; i < 8; ++i) v[i] = src[64 * (i0 + i)];
#pragma unroll
            for (int i = 0; i < 8; ++i) dst[64 * (i0 + i)] = v[i]; }
        { f32x4 v[6];
#pragma unroll
            for (int i = 0; i < 6; ++i) v[i] = src[64 * (56 + i)];
#pragma unroll
            for (int i = 0; i < 6; ++i) dst[64 * (56 + i)] = v[i]; }
    }
}

struct SchedPlain {
    const char* A; const char* Bt; int lda, ldb, nM, nN, nt, G, c, rs; unsigned* q; volatile LAS unsigned* bc;
    __device__ __forceinline__ bool next(int i, gm::Unit& u) const {
        long L;
        if (i < rs) L = (long)i * G + c;
        else {
            if (threadIdx.x == 0) bc[0] = __hip_atomic_fetch_add(q, 1u, __ATOMIC_RELAXED, __HIP_MEMORY_SCOPE_AGENT);
            asm volatile("s_waitcnt lgkmcnt(0)" ::: "memory"); __builtin_amdgcn_s_barrier(); asm volatile("" ::: "memory");
            L = (long)rs * G + (long)bc[0];
        }
        if (L >= (long)nM * nN) return false;
        gm::tile_of((int)L, nM, nN, u.pm, u.pn); u.part = 0; u.nt = nt;
        u.A = A + (size_t)u.pm * 256 * lda * 2; u.B = Bt + (size_t)u.pn * 256 * ldb * 2; return true;
    }
    __device__ __forceinline__ void a_ready(const gm::Unit&) const {}
};
__device__ __forceinline__ int tail_slot(int bx, int G) {
    if (G != 256) return bx;
    const int x = bx & 7, k = bx >> 3; return (x >> 1) * 64 + (k & 3) * 16 + (x & 1) * 8 + (k >> 2);
}
__device__ __forceinline__ bool panel_wait(unsigned* cnt, unsigned need, unsigned* tmo) {
    unsigned sp = 0; bool ok = true;
    while ((unsigned)__builtin_amdgcn_readfirstlane(__hip_atomic_load(cnt, __ATOMIC_RELAXED, __HIP_MEMORY_SCOPE_AGENT)) < need) {
        __builtin_amdgcn_s_sleep(2);
        if ((++sp & 255u) == 0u) { if (__hip_atomic_load(tmo, __ATOMIC_RELAXED, __HIP_MEMORY_SCOPE_AGENT)) { ok = false; break; }
            if (sp > (1u << 20)) { __hip_atomic_store(tmo, 1u, __ATOMIC_RELAXED, __HIP_MEMORY_SCOPE_AGENT); ok = false; break; } }
    }
    __builtin_amdgcn_fence(__ATOMIC_ACQUIRE, "agent");
    asm volatile("s_waitcnt vmcnt(0)" ::: "memory");
    return ok;
}
__device__ __forceinline__ void panel_signal(unsigned* cnt) {
    asm volatile("s_waitcnt vmcnt(0)" ::: "memory");
    __builtin_amdgcn_s_barrier();
    if (threadIdx.x == 0) __hip_atomic_fetch_add(cnt, 1u, __ATOMIC_RELAXED, __HIP_MEMORY_SCOPE_AGENT);
}
__device__ __forceinline__ void store16_wt(__amdgpu_buffer_rsrc_t rs, size_t byte_off, u32x4 v) { __builtin_amdgcn_raw_buffer_store_b128(v, rs, (int)byte_off, 0, 16); }
struct SchedBranch {
    const char* A; const char* Bt; int G, v;
    __device__ __forceinline__ bool next(int i, gm::Unit& u) const {
        const int L = (i >> 1) * G + v; if (L >= NPAN * NCT) return false;
        u.pm = L / NCT; u.pn = L % NCT; u.part = i & 1; u.nt = u.part ? AW / 64 : DM / 64;
        const size_t koff = u.part ? (size_t)DM * 2 : 0;
        u.A = A + (size_t)u.pm * 256 * KBR * 2 + koff; u.B = Bt + (size_t)u.pn * 256 * KBR * 2 + koff; return true;
    }
    __device__ __forceinline__ void a_ready(const gm::Unit&) const {}
};
constexpr int SPL_LO = 448, SPL_HI = 512, SPL_PM0 = SPL_LO / 16, SPL_PM1 = SPL_HI / 16;
struct SchedOut {
    const char* A; const char* Bt; int G, v; unsigned* ctl;
    __device__ __forceinline__ bool next(int i, gm::Unit& u) const {
        const int nB = NPAN * NCT, extra = nB % G; int L, part = 0;
        if (v < extra) { if (i > 0) return false; L = nB - extra + v; }
        else if (G == 256) { const int r = v - extra; if (i < 2) L = i * (G - extra) + r; else { if (i > 2 || r >= 2 * (SPL_HI - SPL_LO)) return false; L = SPL_LO + (r & 63); part = 2 + (r >> 6); } }
        else { L = i * (G - extra) + (v - extra); if (L >= nB - extra) return false; }
        u.pm = L / NCT; u.pn = L % NCT; u.part = part; u.nt = part ? DM / 128 : DM / 64;
        const size_t koff = (part == 3) ? (size_t)(DM / 2) * 2 : 0;
        u.A = A + (size_t)u.pm * 256 * DM * 2 + koff; u.B = Bt + (size_t)u.pn * 256 * DM * 2 + koff; return true;
    }
    __device__ __forceinline__ void a_ready(const gm::Unit& u) const {
        if (threadIdx.x < 64) (void)panel_wait(ctl + CW_BD + 64 * u.pm, NCT, ctl + CW_TMO);
        asm volatile("" ::: "memory"); __builtin_amdgcn_s_barrier(); asm volatile("" ::: "memory");
    }
};

struct EpiIn {
    unsigned char* ws;
    __device__ __forceinline__ bool operator()(f32x4 (&acc)[2][2][4][2], const gm::Unit& u, int wr, int wc, int fr, int fq) const {
        const int pn = u.pn; bf16_t* base; int ldc, ct, act = 0; float sc = 1.f;
        if (pn < 16)      { base = (bf16_t*)(ws + WS_XL); ldc = DM;  ct = pn; }
        else if (pn < 32) { base = (bf16_t*)(ws + WS_GL); ldc = DM;  ct = pn - 16; act = 1; }
        else if (pn < 40) { base = (bf16_t*)(ws + WS_Q);  ldc = AW;  ct = pn - 32; sc = QSCALE; }
        else if (pn < 42) { base = (bf16_t*)(ws + WS_K);  ldc = KVW; ct = pn - 40; }
        else if (pn < 44) { base = (bf16_t*)(ws + WS_V);  ldc = KVW; ct = pn - 42; }
        else if (pn < 52) { base = (bf16_t*)(ws + WS_GA); ldc = AW;  ct = pn - 44; act = 1; }
        else if (pn < 68) { base = (bf16_t*)(ws + WS_MA); ldc = DM;  ct = pn - 52; act = 2; }
        else              { base = (bf16_t*)(ws + WS_MB); ldc = DM;  ct = pn - 68; act = 2; }
        const int row0 = u.pm * 256 + wr * 64 + fr, col0 = ct * 256 + wc * 32 + 8 * fq;
        if (pn == 42 || pn == 43) {
#pragma unroll
            for (int ai = 0; ai < 2; ++ai)
#pragma unroll
                for (int m = 0; m < 4; ++m)
#pragma unroll
                    for (int bj = 0; bj < 2; ++bj)
#pragma unroll
                        for (int n = 0; n < 2; ++n)
#pragma unroll
                            for (int e = 0; e < 4; ++e)
                                base[(size_t)(col0 + bj * 128 + 4 * n + e) * MROWS + row0 + ai * 128 + m * 16] = (bf16_t)(cvtpk(acc[ai][bj][m][n][e], 0.f) & 0xffffu);
            return false;
        }
#pragma unroll
        for (int ai = 0; ai < 2; ++ai)
#pragma unroll
            for (int m = 0; m < 4; ++m) { bf16_t* rowp = base + (size_t)(row0 + ai * 128 + m * 16) * ldc + col0;
#pragma unroll
                for (int bj = 0; bj < 2; ++bj) { f32x4 v0 = acc[ai][bj][m][0], v1 = acc[ai][bj][m][1];
                    if (act == 0) { v0 = v0 * sc; v1 = v1 * sc; }
                    else {
#pragma unroll
                        for (int e = 0; e < 4; ++e) { const float s0 = sigmoidf_(v0[e]), s1 = sigmoidf_(v1[e]); v0[e] = (act == 1) ? v0[e] * s0 : s0; v1[e] = (act == 1) ? v1[e] * s1 : s1; }
                    }
                    u32x4 w; w.x = cvtpk(v0[0], v0[1]); w.y = cvtpk(v0[2], v0[3]); w.z = cvtpk(v1[0], v1[1]); w.w = cvtpk(v1[2], v1[3]);
                    *(u32x4*)(rowp + bj * 128) = w; } }
        return false;
    }
};
struct EpiBranch {
    unsigned char* ws; unsigned* ctl;
    __device__ __forceinline__ bool operator()(f32x4 (&acc)[2][2][4][2], const gm::Unit& u, int wr, int wc, int fr, int fq) const {
        const bf16_t* MA = (const bf16_t*)(ws + WS_MA); const bf16_t* MB = (const bf16_t*)(ws + WS_MB);
        const __amdgpu_buffer_rsrc_t rsMG = __builtin_amdgcn_make_buffer_rsrc(ws + WS_XN, 0, (int)((size_t)MROWS * DM * 2), 0x00020000);
        const int row0 = u.pm * 256 + wr * 64 + fr, col0 = u.pn * 256 + wc * 32 + 8 * fq;
        u32x4 mbv[2][4][2];
#pragma unroll
        for (int ai = 0; ai < 2; ++ai)
#pragma unroll
            for (int m = 0; m < 4; ++m)
#pragma unroll
                for (int bj = 0; bj < 2; ++bj) mbv[ai][m][bj] = *(const u32x4*)(MB + (size_t)(row0 + ai * 128 + m * 16) * DM + col0 + bj * 128);
#pragma unroll
        for (int ai = 0; ai < 2; ++ai)
#pragma unroll
            for (int m = 0; m < 4; ++m) { const size_t off = (size_t)(row0 + ai * 128 + m * 16) * DM + col0;
#pragma unroll
                for (int bj = 0; bj < 2; ++bj) {
                    const u32x4 mb = mbv[ai][m][bj];
                    float sb[8] = {bflo(mb.x), bfhi(mb.x), bflo(mb.y), bfhi(mb.y), bflo(mb.z), bfhi(mb.z), bflo(mb.w), bfhi(mb.w)};
                    if (u.part == 0) {
                        const u32x4 ma = *(const u32x4*)(MA + off + bj * 128);
                        float sa[8] = {bflo(ma.x), bfhi(ma.x), bflo(ma.y), bfhi(ma.y), bflo(ma.z), bfhi(ma.z), bflo(ma.w), bfhi(ma.w)};
#pragma unroll
                        for (int e = 0; e < 4; ++e) { acc[ai][bj][m][0][e] *= sa[e] * __builtin_amdgcn_rcpf(fmaxf(sb[e], 1e-20f)); acc[ai][bj][m][1][e] *= sa[4 + e] * __builtin_amdgcn_rcpf(fmaxf(sb[4 + e], 1e-20f)); }
                    } else {
                        const f32x4 v0 = acc[ai][bj][m][0], v1 = acc[ai][bj][m][1];
                        u32x4 w; w.x = cvtpk(v0[0] * sb[0], v0[1] * sb[1]); w.y = cvtpk(v0[2] * sb[2], v0[3] * sb[3]); w.z = cvtpk(v1[0] * sb[4], v1[1] * sb[5]); w.w = cvtpk(v1[2] * sb[6], v1[3] * sb[7]);
                        store16_wt(rsMG, (off + bj * 128) * 2, w);
                    } } }
        if (u.part) panel_signal(ctl + CW_BD + 64 * u.pm);
        return u.part == 0;
    }
};
struct EpiOut {
    unsigned char* ws; unsigned* ctl;
    __device__ __forceinline__ bool operator()(f32x4 (&acc)[2][2][4][2], const gm::Unit& u, int wr, int wc, int fr, int fq) const {
        const bool second = (u.part == 3);
        const __amdgpu_buffer_rsrc_t rsOF = second ? __builtin_amdgcn_make_buffer_rsrc(ws + WS_OF1, 0, (int)((size_t)(SPL_PM1 - SPL_PM0) * 256 * DM * 2), 0x00020000)
                                                   : __builtin_amdgcn_make_buffer_rsrc(ws + WS_HLOC, 0, (int)((size_t)MROWS * DM * 2), 0x00020000);
        const int row0 = (second ? u.pm - SPL_PM0 : u.pm) * 256 + wr * 64 + fr, col0 = u.pn * 256 + wc * 32 + 8 * fq;
#pragma unroll
        for (int ai = 0; ai < 2; ++ai)
#pragma unroll
            for (int m = 0; m < 4; ++m) { const size_t ro = (size_t)(row0 + ai * 128 + m * 16) * DM + col0;
#pragma unroll
                for (int bj = 0; bj < 2; ++bj) { const f32x4 v0 = acc[ai][bj][m][0], v1 = acc[ai][bj][m][1];
                    u32x4 w; w.x = cvtpk(v0[0], v0[1]); w.y = cvtpk(v0[2], v0[3]); w.z = cvtpk(v1[0], v1[1]); w.w = cvtpk(v1[2], v1[3]);
                    store16_wt(rsOF, (ro + bj * 128) * 2, w); } }
        panel_signal(ctl + CW_OD + 64 * u.pm);
        return false;
    }
};

__device__ __forceinline__ int xc_byte(int row, int k) { return row * 512 + ((k * 2) ^ ((row & 15) << 4)); }
template <int D> __device__ __forceinline__ float dpp_shr(float v, float fill) {
    return __int_as_float(__builtin_amdgcn_update_dpp(__float_as_int(fill), __float_as_int(v), 0x110 + D, 0xF, 0xF, false));
}
template <int D> __device__ __forceinline__ void scan_step(float& A, float& H, bool on) {
    const float pa = dpp_shr<D>(A, 1.0f), ph = dpp_shr<D>(H, 0.0f);
    if (on) { H = A * ph + H; A = pa * A; }
}
template <int D> __device__ __forceinline__ void scan4(float& H0, float& H1, float& H2, float& H3, float& A0, float& A1, float& A2, float& A3) {
    if (D == 1) asm volatile("s_nop 1");
    asm volatile(
        "v_fmac_f32_dpp %0, %0, %4 row_shr:%c8 row_mask:0xf bank_mask:0xf\n\t"
        "v_fmac_f32_dpp %1, %1, %5 row_shr:%c8 row_mask:0xf bank_mask:0xf\n\t"
        "v_fmac_f32_dpp %2, %2, %6 row_shr:%c8 row_mask:0xf bank_mask:0xf\n\t"
        "v_fmac_f32_dpp %3, %3, %7 row_shr:%c8 row_mask:0xf bank_mask:0xf\n\t"
        "v_mul_f32_dpp %4, %4, %4 row_shr:%c8 row_mask:0xf bank_mask:0xf\n\t"
        "v_mul_f32_dpp %5, %5, %5 row_shr:%c8 row_mask:0xf bank_mask:0xf\n\t"
        "v_mul_f32_dpp %6, %6, %6 row_shr:%c8 row_mask:0xf bank_mask:0xf\n\t"
        "v_mul_f32_dpp %7, %7, %7 row_shr:%c8 row_mask:0xf bank_mask:0xf"
        : "+v"(H0), "+v"(H1), "+v"(H2), "+v"(H3), "+v"(A0), "+v"(A1), "+v"(A2), "+v"(A3) : "i"(D));
}
template <bool SAMP>
__device__ __forceinline__ void lru_item(const Frame& F, const Args& a, int c, int j) {
    unsigned char* ws = a.ws;
    const bf16_t* XL = (const bf16_t*)(ws + WS_XL);
    int tid = F.tid; asm volatile("" : "+v"(tid));
    const int lane = tid & 63, w = F.wave;
    LAS unsigned char* At = F.lds;
    const int row0 = c * 128;
    {
        const int cg = tid & 31, rg = tid >> 5, chb = j * BLK + cg * 8, r0 = row0 + rg * 8;
        float cw[4][8], cb[8];
#pragma unroll
        for (int t = 0; t < 4; ++t) { const f32x4 w0 = *(const f32x4*)(a.in[I_CONVW] + (size_t)t * DM + chb), w1 = *(const f32x4*)(a.in[I_CONVW] + (size_t)t * DM + chb + 4);
#pragma unroll
            for (int e = 0; e < 4; ++e) { cw[t][e] = w0[e]; cw[t][4 + e] = w1[e]; } }
        { const f32x4 b0 = *(const f32x4*)(a.in[I_CONVB] + chb), b1 = *(const f32x4*)(a.in[I_CONVB] + chb + 4);
#pragma unroll
            for (int e = 0; e < 4; ++e) { cb[e] = b0[e]; cb[4 + e] = b1[e]; } }
        u32x4 xr[8];
#pragma unroll
        for (int i = 0; i < 8; ++i) xr[i] = *(const u32x4*)(XL + (size_t)(r0 + i) * DM + chb);
        float h3[8], h2[8], h1[8];
#define UNPK(dst, v) do { dst[0] = bflo(v.x); dst[1] = bfhi(v.x); dst[2] = bflo(v.y); dst[3] = bfhi(v.y); dst[4] = bflo(v.z); dst[5] = bfhi(v.z); dst[6] = bflo(v.w); dst[7] = bfhi(v.w); } while (0)
        if (!SAMP) {
            if (r0 >= 3) { const u32x4 p3 = *(const u32x4*)(XL + (size_t)(r0 - 3) * DM + chb), p2 = *(const u32x4*)(XL + (size_t)(r0 - 2) * DM + chb), p1 = *(const u32x4*)(XL + (size_t)(r0 - 1) * DM + chb);
                UNPK(h3, p3); UNPK(h2, p2); UNPK(h1, p1); }
            else {
#pragma unroll
                for (int e = 0; e < 8; ++e) { h3[e] = 0.f; h2[e] = 0.f; h1[e] = 0.f; } }
        }
#pragma unroll
        for (int i = 0; i < 8; ++i) {
            if (SAMP && (i & 3) == 0) {
                const int b = (r0 + i - SEQ) >> 2; const float* sc = a.in[I_SCONV] + (size_t)b * 3 * DM + chb;
                const f32x4 a0 = *(const f32x4*)(sc), a1 = *(const f32x4*)(sc + 4), b0 = *(const f32x4*)(sc + DM), b1 = *(const f32x4*)(sc + DM + 4), c0 = *(const f32x4*)(sc + 2 * DM), c1 = *(const f32x4*)(sc + 2 * DM + 4);
#pragma unroll
                for (int e = 0; e < 4; ++e) { h3[e] = a0[e]; h3[4 + e] = a1[e]; h2[e] = b0[e]; h2[4 + e] = b1[e]; h1[e] = c0[e]; h1[4 + e] = c1[e]; }
            }
            float x[8]; UNPK(x, xr[i]);
            float o[8];
#pragma unroll
            for (int e = 0; e < 8; ++e) { o[e] = cb[e] + cw[0][e] * h3[e] + cw[1][e] * h2[e] + cw[2][e] * h1[e] + cw[3][e] * x[e]; h3[e] = h2[e]; h2[e] = h1[e]; h1[e] = x[e]; }
            u32x4 pk; pk.x = cvtpk(o[0], o[1]); pk.y = cvtpk(o[2], o[3]); pk.z = cvtpk(o[4], o[5]); pk.w = cvtpk(o[6], o[7]);
            *(LAS u32x4*)(At + xc_byte(rg * 8 + i, cg * 8)) = pk;
        }
#undef UNPK
    }
    __syncthreads();
    const int fr = lane & 15, fq = lane >> 4;
    unsigned* HA = (unsigned*)(ws + WS_HLOC); bf16_t* OAB = (bf16_t*)(ws + WS_OAB); const bf16_t* GL = (const bf16_t*)(ws + WS_GL);
#pragma unroll 1
    for (int nt = 0; nt < 2; ++nt) {
        const int nb = 32 * w + 16 * nt, chl = nb + 4 * fq, ch = j * BLK + chl;
        f32x4 acc[8][2];
#pragma unroll
        for (int m = 0; m < 8; ++m)
#pragma unroll
            for (int g = 0; g < 2; ++g) acc[m][g] = (f32x4){0.f, 0.f, 0.f, 0.f};
        {
            const bf16_t* WGb = (const bf16_t*)(ws + WS_WG) + (size_t)(j * 2) * BLK * BLK + (size_t)(nb + fr) * BLK + 8 * fq;
#pragma unroll
            for (int ks = 0; ks < 8; ++ks) {
                bf16x8 wf[2];
#pragma unroll
                for (int g = 0; g < 2; ++g) wf[g] = *(const bf16x8*)(WGb + (size_t)g * BLK * BLK + 32 * ks);
#pragma unroll
                for (int m = 0; m < 8; ++m) { const bf16x8 xf = *(const LAS bf16x8*)(At + xc_byte(16 * m + fr, 32 * ks + 8 * fq));
                    acc[m][0] = __builtin_amdgcn_mfma_f32_16x16x32_bf16(wf[0], xf, acc[m][0], 0, 0, 0); acc[m][1] = __builtin_amdgcn_mfma_f32_16x16x32_bf16(wf[1], xf, acc[m][1], 0, 0, 0); }
            }
        }
        const float* lc = (const float*)(ws + WS_LC) + ch;
        const f32x4 nba = *(const f32x4*)lc, nbx = *(const f32x4*)(lc + DM), nc8l = *(const f32x4*)(lc + 2 * DM);
        float Av[8][4], Hv[8][4];
#pragma unroll
        for (int m = 0; m < 8; ++m) {
            const u32x2 xw = *(const LAS u32x2*)(At + xc_byte(16 * m + fr, chl));
            const float xcv[4] = {bflo(xw.x), bfhi(xw.x), bflo(xw.y), bfhi(xw.y)};
#pragma unroll
            for (int r = 0; r < 4; ++r) {
                const float ga = __builtin_amdgcn_rcpf(1.0f + __builtin_amdgcn_exp2f(__builtin_fmaf(acc[m][0][r], -LOG2E, nba[r])));
                const float gx = __builtin_amdgcn_rcpf(1.0f + __builtin_amdgcn_exp2f(__builtin_fmaf(acc[m][1][r], -LOG2E, nbx[r])));
                const float av = __builtin_amdgcn_exp2f(nc8l[r] * ga);
                const float m2 = __builtin_fmaf(-av, av, 1.0f);
                Av[m][r] = av; Hv[m][r] = __builtin_amdgcn_sqrtf(m2) * (gx * xcv[r]);
            }
            if (SAMP) {
#pragma unroll
                for (int r = 0; r < 4; ++r) { scan_step<1>(Av[m][r], Hv[m][r], (fr & 3) >= 1); scan_step<2>(Av[m][r], Hv[m][r], (fr & 3) >= 2); }
            } else {
                scan4<1>(Hv[m][0], Hv[m][1], Hv[m][2], Hv[m][3], Av[m][0], Av[m][1], Av[m][2], Av[m][3]);
                scan4<2>(Hv[m][0], Hv[m][1], Hv[m][2], Hv[m][3], Av[m][0], Av[m][1], Av[m][2], Av[m][3]);
                scan4<4>(Hv[m][0], Hv[m][1], Hv[m][2], Hv[m][3], Av[m][0], Av[m][1], Av[m][2], Av[m][3]);
                scan4<8>(Hv[m][0], Hv[m][1], Hv[m][2], Hv[m][3], Av[m][0], Av[m][1], Av[m][2], Av[m][3]);
            }
            __builtin_amdgcn_sched_barrier(0);
        }
        if (SAMP) {
#pragma unroll
            for (int m = 0; m < 8; ++m) {
                const int row = row0 + 16 * m + fr, b = (row - SEQ) >> 2;
                const f32x4 h0 = *(const f32x4*)(a.in[I_SH] + (size_t)b * DM + ch);
                const u32x2 gw = *(const u32x2*)(GL + (size_t)row * DM + ch);
                f32x4 h;
#pragma unroll
                for (int r = 0; r < 4; ++r) h[r] = Av[m][r] * h0[r] + Hv[m][r];
                u32x2 o; o.x = cvtpk(h[0] * bflo(gw.x), h[1] * bfhi(gw.x)); o.y = cvtpk(h[2] * bflo(gw.y), h[3] * bfhi(gw.y));
                *(u32x2*)(OAB + (size_t)row * KBR + ch) = o;
                if ((fr & 3) == 3) *(f32x4*)(a.out + O_HS + (size_t)b * DM + ch) = h;
            }
        } else {
            f32x4 CA = (f32x4){1.f, 1.f, 1.f, 1.f}, CH = (f32x4){0.f, 0.f, 0.f, 0.f};
            const int bsel = (lane | 15) << 2;
#pragma unroll
            for (int m = 0; m < 8; ++m) {
                u32x4 o; f32x4 TA, TH;
#pragma unroll
                for (int r = 0; r < 4; ++r) { TA[r] = __int_as_float(__builtin_amdgcn_ds_bpermute(bsel, __float_as_int(Av[m][r]))); TH[r] = __int_as_float(__builtin_amdgcn_ds_bpermute(bsel, __float_as_int(Hv[m][r])));
                    o[r] = cvtpk(CA[r] * Av[m][r], Av[m][r] * CH[r] + Hv[m][r]); }
                *(u32x4*)(HA + (size_t)(row0 + 16 * m + fr) * DM + ch) = o;
#pragma unroll
                for (int r = 0; r < 4; ++r) { CH[r] = TA[r] * CH[r] + TH[r]; CA[r] = CA[r] * TA[r]; }
            }
            if (fr == 0) { *(f32x4*)((float*)(ws + WS_CARA) + (size_t)c * DM + ch) = CA; *(f32x4*)((float*)(ws + WS_CARH) + (size_t)c * DM + ch) = CH; }
        }
    }
    __syncthreads();
}

__device__ __forceinline__ int crow(int r, int hi) { return (r & 3) + 8 * (r >> 2) + 4 * hi; }
constexpr int AT_KSTR = 144, AT_VSTR = 520, AT_K = 0, AT_V = 256 * AT_KSTR, AT_O = AT_V + 64 * AT_VSTR;
static_assert(AT_O % 16 == 0 && AT_O + 8 * 4096 <= RING_BYTES, "attention LDS map");

__device__ __forceinline__ void attn_item(const Frame& F, const Args& a, int b, int g) {
    unsigned char* ws = a.ws;
    const bf16_t* Qb = (const bf16_t*)(ws + WS_Q); const bf16_t* Kb = (const bf16_t*)(ws + WS_K); const bf16_t* VT = (const bf16_t*)(ws + WS_V);
    const bf16_t* GA = (const bf16_t*)(ws + WS_GA); bf16_t* OAB = (bf16_t*)(ws + WS_OAB);
    int tid = F.tid; asm volatile("" : "+v"(tid));
    const int lane = tid & 63, w = F.wave, r = lane & 31, h = lane >> 5;
    LAS unsigned char* Kt = F.lds + AT_K; LAS unsigned char* Vt = F.lds + AT_V; LAS unsigned char* Ost = F.lds + AT_O + w * 4096;
    bf16x8 qfa[2][4]; u32x4 gaa[2][4];
#pragma unroll
    for (int si = 0; si < 2; ++si) { const int s_ = 2 * (w >> 2) + si, head_ = 4 * g + (w & 3);
#pragma unroll
        for (int ds = 0; ds < 4; ++ds) qfa[si][ds] = *(const bf16x8*)(Qb + (size_t)(128 * b + 32 * s_ + r) * AW + head_ * HD + 16 * ds + 8 * h);
#pragma unroll
        for (int i = 0; i < 4; ++i) gaa[si][i] = *(const u32x4*)(GA + (size_t)(128 * b + 32 * s_ + i * 8 + (lane >> 3)) * AW + head_ * HD + (lane & 7) * 8); }
    u32x4 kv[4], vv[4];
#pragma unroll
    for (int i = 0; i < 4; ++i) { const int p = tid + 512 * i, key = p >> 3, ck = p & 7; const int kr = 128 * (b - 1) + key;
        kv[i] = *(const u32x4*)(Kb + (size_t)(kr < 0 ? 0 : kr) * KVW + g * HD + ck * 8); }
#pragma unroll
    for (int i = 0; i < 4; ++i) { const int p = tid + 512 * i, d = p >> 5, ck = p & 31; const int tk = 128 * (b - 1) + ck * 8;
        vv[i] = *(const u32x4*)(VT + (size_t)(g * HD + d) * MROWS + (tk < 0 ? 0 : tk)); }
#pragma unroll
    for (int i = 0; i < 4; ++i) { const int p = tid + 512 * i, key = p >> 3, ck = p & 7;
        const u32x4 v = (b > 0 || key >= 128) ? kv[i] : (u32x4){0u, 0u, 0u, 0u};
        *(LAS u32x4*)(Kt + key * AT_KSTR + ck * 16) = v; }
#pragma unroll
    for (int i = 0; i < 4; ++i) { const int p = tid + 512 * i, d = p >> 5, ck = p & 31;
        const u32x4 v = (b > 0 || ck >= 16) ? vv[i] : (u32x4){0u, 0u, 0u, 0u};
        *(LAS u32x2*)(Vt + d * AT_VSTR + ck * 16) = (u32x2){v.x, v.y}; *(LAS u32x2*)(Vt + d * AT_VSTR + ck * 16 + 8) = (u32x2){v.z, v.w}; }
    __syncthreads();
    const int hq = w & 3, head = 4 * g + hq;
    const float sink2 = a.in[I_SINK][head] * LOG2E;
#pragma unroll
    for (int si = 0; si < 2; ++si) {
        const int s = 2 * (w >> 2) + si;
        const bf16x8 (&qf)[4] = qfa[si];
        f32x16 st[5];
#pragma unroll
        for (int tt = 0; tt < 5; ++tt) {
            st[tt] = (f32x16){};
            const LAS unsigned char* kp = Kt + (32 * (s + tt) + r) * AT_KSTR + 16 * h;
#pragma unroll
            for (int ds = 0; ds < 4; ++ds) st[tt] = __builtin_amdgcn_mfma_f32_32x32x16_bf16(*(const LAS bf16x8*)(kp + 32 * ds), qf[ds], st[tt], 0, 0, 0);
        }
        float mx = -1e30f;
#pragma unroll
        for (int tt = 0; tt < 5; ++tt) {
            const bool dead = (b == 0) && (s + tt < 4);
#pragma unroll
            for (int e = 0; e < 16; ++e) { const int cr = crow(e, h); const bool ok = !dead && (tt != 0 || cr >= r) && (tt != 4 || cr <= r);
                st[tt][e] = ok ? st[tt][e] : -1e30f; mx = fmaxf(mx, st[tt][e]); }
        }
        mx = fmaxf(mx, __shfl_xor(mx, 32)); mx = fmaxf(mx, sink2);
        float sum = 0.f;
#pragma unroll
        for (int tt = 0; tt < 5; ++tt)
#pragma unroll
            for (int e = 0; e < 16; ++e) { const float p = __builtin_amdgcn_exp2f(st[tt][e] - mx); st[tt][e] = p; sum += p; }
        sum += __shfl_xor(sum, 32); sum += __builtin_amdgcn_exp2f(sink2 - mx);
        const float inv = __builtin_amdgcn_rcpf(sum);
        f32x16 o[2]; o[0] = (f32x16){}; o[1] = (f32x16){};
#pragma unroll
        for (int tt = 0; tt < 5; ++tt)
#pragma unroll
            for (int ks = 0; ks < 2; ++ks) {
                u32x4 pw; pw.x = cvtpk(st[tt][8 * ks + 0] * inv, st[tt][8 * ks + 1] * inv); pw.y = cvtpk(st[tt][8 * ks + 2] * inv, st[tt][8 * ks + 3] * inv);
                pw.z = cvtpk(st[tt][8 * ks + 4] * inv, st[tt][8 * ks + 5] * inv); pw.w = cvtpk(st[tt][8 * ks + 6] * inv, st[tt][8 * ks + 7] * inv);
                const bf16x8 pa = __builtin_bit_cast(bf16x8, pw);
#pragma unroll
                for (int dh = 0; dh < 2; ++dh) { const LAS unsigned char* vp = Vt + (32 * dh + r) * AT_VSTR + (32 * (s + tt) + 16 * ks + 4 * h) * 2;
                    const u32x2 lo = *(const LAS u32x2*)vp, hi2 = *(const LAS u32x2*)(vp + 16);
                    const u32x4 vw = (u32x4){lo.x, lo.y, hi2.x, hi2.y};
                    o[dh] = __builtin_amdgcn_mfma_f32_32x32x16_bf16(pa, __builtin_bit_cast(bf16x8, vw), o[dh], 0, 0, 0); }
            }
#pragma unroll
        for (int e = 0; e < 16; ++e)
#pragma unroll
            for (int dh = 0; dh < 2; ++dh) *(LAS unsigned short*)(Ost + crow(e, h) * 128 + (32 * dh + r) * 2) = (unsigned short)(cvtpk(o[dh][e], 0.f) & 0xffffu);
        LDS_WAIT();
#pragma unroll
        for (int i = 0; i < 4; ++i) { const int row = i * 8 + (lane >> 3), ck = lane & 7; const size_t grow = (size_t)(128 * b + 32 * s + row);
            const u32x4 ov = *(const LAS u32x4*)(Ost + row * 128 + ck * 16);
            const u32x4 gv = gaa[si][i];
            u32x4 res; res.x = cvtpk(bflo(ov.x) * bflo(gv.x), bfhi(ov.x) * bfhi(gv.x)); res.y = cvtpk(bflo(ov.y) * bflo(gv.y), bfhi(ov.y) * bfhi(gv.y));
            res.z = cvtpk(bflo(ov.z) * bflo(gv.z), bfhi(ov.z) * bfhi(gv.z)); res.w = cvtpk(bflo(ov.w) * bflo(gv.w), bfhi(ov.w) * bfhi(gv.w));
            *(u32x4*)(OAB + grow * KBR + DM + head * HD + ck * 8) = res; }
        LDS_WAIT();
    }
    __syncthreads();
}

__device__ __forceinline__ void attn_sample_unit(const Frame& F, const Args& a, int u) {
    unsigned char* ws = a.ws;
    const bf16_t* Qb = (const bf16_t*)(ws + WS_Q); const bf16_t* Kb = (const bf16_t*)(ws + WS_K); const bf16_t* VT = (const bf16_t*)(ws + WS_V);
    const bf16_t* KC = (const bf16_t*)(ws + WS_KC); const bf16_t* VCT = (const bf16_t*)(ws + WS_VCT);
    const bf16_t* GA = (const bf16_t*)(ws + WS_GA); bf16_t* OAB = (bf16_t*)(ws + WS_OAB);
    int lane = F.lane; asm volatile("" : "+v"(lane)); asm volatile("" : "+s"(u));
    const int r = lane & 31, h = lane >> 5, sb = u >> 3, g = u & 7;
    const int qrow = SEQ + 4 * sb + (r & 3), head = 4 * g + ((r >> 2) & 3), qi = r & 3;
    bf16x8 qf[4];
#pragma unroll
    for (int ds = 0; ds < 4; ++ds) qf[ds] = *(const bf16x8*)(Qb + (size_t)qrow * AW + head * HD + 16 * ds + 8 * h);
    const float sink2 = a.in[I_SINK][head] * LOG2E;
    f32x16 st[5];
#pragma unroll
    for (int T = 0; T < 5; ++T) {
        st[T] = (f32x16){};
        const bf16_t* kp;
        if (T < 4) kp = KC + ((size_t)sb * WIN + 32 * T + r) * KVW + g * HD + 8 * h;
        else { int krow = SEQ + 4 * sb + r; krow = krow < MROWS ? krow : MROWS - 1; kp = Kb + (size_t)krow * KVW + g * HD + 8 * h; }
#pragma unroll
        for (int ds = 0; ds < 4; ++ds) st[T] = __builtin_amdgcn_mfma_f32_32x32x16_bf16(*(const bf16x8*)(kp + 16 * ds), qf[ds], st[T], 0, 0, 0);
    }
    float mx = -1e30f;
#pragma unroll
    for (int T = 0; T < 5; ++T)
#pragma unroll
        for (int e = 0; e < 16; ++e) { const int kk = 32 * T + crow(e, h); const bool ok = (kk >= qi) && (kk <= qi + WIN);
            st[T][e] = ok ? st[T][e] : -1e30f; mx = fmaxf(mx, st[T][e]); }
    mx = fmaxf(mx, __shfl_xor(mx, 32)); mx = fmaxf(mx, sink2);
    float sum = 0.f;
#pragma unroll
    for (int T = 0; T < 5; ++T)
#pragma unroll
        for (int e = 0; e < 16; ++e) { const float p = __builtin_amdgcn_exp2f(st[T][e] - mx); st[T][e] = p; sum += p; }
    sum += __shfl_xor(sum, 32); sum += __builtin_amdgcn_exp2f(sink2 - mx);
    const float inv = __builtin_amdgcn_rcpf(sum);
    f32x16 o[2]; o[0] = (f32x16){}; o[1] = (f32x16){};
#pragma unroll
    for (int T = 0; T < 5; ++T)
#pragma unroll
        for (int ks = 0; ks < 2; ++ks) {
            if (T == 4 && ks == 1) continue;
            u32x4 pw; pw.x = cvtpk(st[T][8 * ks + 0] * inv, st[T][8 * ks + 1] * inv); pw.y = cvtpk(st[T][8 * ks + 2] * inv, st[T][8 * ks + 3] * inv);
            pw.z = cvtpk(st[T][8 * ks + 4] * inv, st[T][8 * ks + 5] * inv); pw.w = cvtpk(st[T][8 * ks + 6] * inv, st[T][8 * ks + 7] * inv);
            const bf16x8 pa = __builtin_bit_cast(bf16x8, pw);
#pragma unroll
            for (int dh = 0; dh < 2; ++dh) {
                u32x2 lo, hi2;
                if (T < 4) { const bf16_t* vp = VCT + ((size_t)sb * KVW + g * HD + 32 * dh + r) * WIN + 32 * T + 16 * ks + 4 * h; lo = *(const u32x2*)vp; hi2 = *(const u32x2*)(vp + 8); }
                else { const bf16_t* vp = VT + (size_t)(g * HD + 32 * dh + r) * MROWS + SEQ + 4 * sb; lo = *(const u32x2*)vp; if (h) { lo.x = 0u; lo.y = 0u; } hi2.x = 0u; hi2.y = 0u; }
                const u32x4 vw = (u32x4){lo.x, lo.y, hi2.x, hi2.y};
                o[dh] = __builtin_amdgcn_mfma_f32_32x32x16_bf16(pa, __builtin_bit_cast(bf16x8, vw), o[dh], 0, 0, 0);
            }
        }
#pragma unroll
    for (int e = 0; e < 16; ++e) {
        const int qq = crow(e, h); if (qq >= 16) continue;
        const int orow = SEQ + 4 * sb + (qq & 3), ohead = 4 * g + ((qq >> 2) & 3);
#pragma unroll
        for (int dh = 0; dh < 2; ++dh) { const int cidx = ohead * HD + 32 * dh + r;
            OAB[(size_t)orow * KBR + DM + cidx] = (bf16_t)(cvtpk(o[dh][e] * bf2f(GA[(size_t)orow * AW + cidx]), 0.f) & 0xffffu); }
    }
}

__device__ __forceinline__ void p2_mixers(const Frame& F, const Args& a) {
    unsigned char* ws = a.ws;
#ifndef DUP_SUB
#define DUP_SUB 0
#endif
    {
        constexpr int nL = (MROWS / 128) * NBLK, nA = (SEQ / 128) * NKV, nS = DECB * NKV / NWAVES, nT = nL + nA + nS;
        volatile LAS unsigned* bc = (volatile LAS unsigned*)(F.lds + MISC_OFF + 64);
        unsigned* q = (unsigned*)(ws + WS_CTL) + CW_Q2;
        if (F.tid == 0) bc[0] = __hip_atomic_fetch_add(q, 1u, __ATOMIC_RELAXED, __HIP_MEMORY_SCOPE_AGENT);
        __syncthreads();
        int cur = (int)bc[0];
        __syncthreads();
        while (cur < nT) {
            unsigned nxt = 0u;
            if (F.tid == 0) nxt = __hip_atomic_fetch_add(q, 1u, __ATOMIC_RELAXED, __HIP_MEMORY_SCOPE_AGENT);
            if (cur < nL) { const int c = cur / NBLK, j = cur % NBLK; if (c < SEQ / 128) lru_item<false>(F, a, c, j); else lru_item<true>(F, a, c, j); }
            else if (cur < nL + nA) { const int it = cur - nL; attn_item(F, a, it / NKV, it % NKV); }
            else attn_sample_unit(F, a, (cur - nL - nA) * NWAVES + F.wave);
            if (F.tid == 0) bc[0] = nxt;
            __syncthreads();
            cur = (int)bc[0];
            __syncthreads();
        }
    }
    for (int rp = 0; rp < (DUP_SUB == 4 ? 2 : 1); ++rp) {
    const bf16_t* XL = (const bf16_t*)(ws + WS_XL); const bf16_t* Kb = (const bf16_t*)(ws + WS_K); const bf16_t* VT = (const bf16_t*)(ws + WS_V);
    const size_t gt = (size_t)F.vcu * 512 + F.tid, NT = (size_t)F.G * 512;
    for (size_t i = gt; i < (size_t)WIN * KVW; i += NT) { a.out[O_KP + i] = bf2f(Kb[(size_t)(SEQ - WIN) * KVW + i]); a.out[O_VP + i] = bf2f(VT[(i % KVW) * MROWS + (SEQ - WIN) + i / KVW]); }
    for (size_t i = gt; i < (size_t)DECB * DECT * KVW; i += NT) { const size_t b = i / (DECT * KVW), rem = i % (DECT * KVW);
        a.out[O_KS + b * WIN * KVW + (size_t)(WIN - DECT) * KVW + rem] = bf2f(Kb[(size_t)SEQ * KVW + i]); a.out[O_VS + b * WIN * KVW + (size_t)(WIN - DECT) * KVW + rem] = bf2f(VT[(i % KVW) * MROWS + SEQ + i / KVW]); }
    for (size_t i = gt; i < (size_t)3 * DM; i += NT) a.out[O_CP + i] = bf2f(XL[(size_t)(SEQ - 3) * DM + i]);
    for (size_t i = gt; i < (size_t)DECB * 3 * DM; i += NT) { const size_t b = i / (3 * DM), rem = i % (3 * DM); a.out[O_CS + i] = bf2f(XL[((size_t)SEQ + 4 * b + 1) * DM + rem]); }
    }
}

__device__ __forceinline__ void p3_carry(const Frame& F, const Args& a) {
    unsigned char* ws = a.ws;
    const unsigned* HA = (const unsigned*)(ws + WS_HLOC); const bf16_t* GL = (const bf16_t*)(ws + WS_GL); bf16_t* OAB = (bf16_t*)(ws + WS_OAB);
    const float* CARA = (const float*)(ws + WS_CARA); const float* CARH = (const float*)(ws + WS_CARH);
    for (int it = F.vcu; it < (SEQ / 128) * 4; it += F.G) {
        const int c = it >> 2, qd = it & 3, cg = F.tid & 127, rg = F.tid >> 7, ch0 = 1024 * qd + 8 * cg;
        float hin[8];
#pragma unroll
        for (int e = 0; e < 8; ++e) hin[e] = 0.f;
#pragma unroll 4
        for (int cc = 0; cc < c; ++cc) {
            const f32x4 a0 = *(const f32x4*)(CARA + (size_t)cc * DM + ch0), a1 = *(const f32x4*)(CARA + (size_t)cc * DM + ch0 + 4), h0 = *(const f32x4*)(CARH + (size_t)cc * DM + ch0), h1 = *(const f32x4*)(CARH + (size_t)cc * DM + ch0 + 4);
#pragma unroll
            for (int e = 0; e < 4; ++e) { hin[e] = a0[e] * hin[e] + h0[e]; hin[4 + e] = a1[e] * hin[4 + e] + h1[e]; }
        }
        if (c == SEQ / 128 - 1 && rg == 0) {
            const f32x4 a0 = *(const f32x4*)(CARA + (size_t)c * DM + ch0), a1 = *(const f32x4*)(CARA + (size_t)c * DM + ch0 + 4), h0 = *(const f32x4*)(CARH + (size_t)c * DM + ch0), h1 = *(const f32x4*)(CARH + (size_t)c * DM + ch0 + 4);
            f32x4 o0, o1;
#pragma unroll
            for (int e = 0; e < 4; ++e) { o0[e] = a0[e] * hin[e] + h0[e]; o1[e] = a1[e] * hin[4 + e] + h1[e]; }
            *(f32x4*)(a.out + O_HP + ch0) = o0; *(f32x4*)(a.out + O_HP + ch0 + 4) = o1;
        }
#pragma unroll 1
        for (int r4 = 0; r4 < 32; r4 += 4) {
            u32x4 p0[4], p1[4], gl[4];
#pragma unroll
            for (int k = 0; k < 4; ++k) { const size_t row = (size_t)c * 128 + rg * 32 + r4 + k;
                p0[k] = *(const u32x4*)(HA + row * DM + ch0); p1[k] = *(const u32x4*)(HA + row * DM + ch0 + 4); gl[k] = *(const u32x4*)(GL + row * DM + ch0); }
#pragma unroll
            for (int k = 0; k < 4; ++k) { const size_t row = (size_t)c * 128 + rg * 32 + r4 + k;
                u32x4 o;
                o.x = cvtpk((bfhi(p0[k].x) + bflo(p0[k].x) * hin[0]) * bflo(gl[k].x), (bfhi(p0[k].y) + bflo(p0[k].y) * hin[1]) * bfhi(gl[k].x));
                o.y = cvtpk((bfhi(p0[k].z) + bflo(p0[k].z) * hin[2]) * bflo(gl[k].y), (bfhi(p0[k].w) + bflo(p0[k].w) * hin[3]) * bfhi(gl[k].y));
                o.z = cvtpk((bfhi(p1[k].x) + bflo(p1[k].x) * hin[4]) * bflo(gl[k].z), (bfhi(p1[k].y) + bflo(p1[k].y) * hin[5]) * bfhi(gl[k].z));
                o.w = cvtpk((bfhi(p1[k].z) + bflo(p1[k].z) * hin[6]) * bflo(gl[k].w), (bfhi(p1[k].w) + bflo(p1[k].w) * hin[7]) * bfhi(gl[k].w));
                *(u32x4*)(OAB + row * KBR + ch0) = o; }
        }
    }
}

__device__ __forceinline__ void final_row(const Frame& F, const Args& a, int m, bool split) {
    unsigned char* ws = a.ws;
    const GAS f32x4* gp = (const GAS f32x4*)a.in[I_NPOST] + 2 * F.lane;
    const float* xrow = (m < SEQ) ? a.in[I_XP] + (size_t)m * DM : a.in[I_XS] + (size_t)(m - SEQ) * DM;
    const GAS f32x4* xr = (const GAS f32x4*)xrow + 2 * F.lane; const GAS u32x4* orow = (const GAS u32x4*)((const bf16_t*)(ws + WS_HLOC) + (size_t)m * DM) + F.lane;
    GAS f32x4* yr = (GAS f32x4*)(a.out + (size_t)m * DM) + 2 * F.lane;
    float o[8][8]; float s = 0.f;
#pragma unroll
    for (int j = 0; j < 8; ++j) { const u32x4 w = orow[64 * j];
        o[j][0] = bflo(w.x); o[j][1] = bfhi(w.x); o[j][2] = bflo(w.y); o[j][3] = bfhi(w.y); o[j][4] = bflo(w.z); o[j][5] = bfhi(w.z); o[j][6] = bflo(w.w); o[j][7] = bfhi(w.w); }
    if (split) { const GAS u32x4* o1 = (const GAS u32x4*)((const bf16_t*)(ws + WS_OF1) + (size_t)(m - SPL_PM0 * 256) * DM) + F.lane;
#pragma unroll
        for (int j = 0; j < 8; ++j) { const u32x4 w = o1[64 * j];
            o[j][0] += bflo(w.x); o[j][1] += bfhi(w.x); o[j][2] += bflo(w.y); o[j][3] += bfhi(w.y); o[j][4] += bflo(w.z); o[j][5] += bfhi(w.z); o[j][6] += bflo(w.w); o[j][7] += bfhi(w.w); } }
#pragma unroll
    for (int j = 0; j < 8; ++j)
#pragma unroll
        for (int e = 0; e < 8; ++e) s += o[j][e] * o[j][e];
    const float sc = 1.0f / sqrtf(wave_sum(s) * (1.0f / DM) + RMS_EPS);
    f32x4 xa[8][2], ga[8][2];
#pragma unroll
    for (int j = 0; j < 8; ++j) { xa[j][0] = xr[128 * j]; xa[j][1] = xr[128 * j + 1]; ga[j][0] = gp[128 * j]; ga[j][1] = gp[128 * j + 1]; }
#pragma unroll
    for (int j = 0; j < 8; ++j) { f32x4 y0, y1;
#pragma unroll
        for (int e = 0; e < 4; ++e) { y0[e] = xa[j][0][e] + o[j][e] * sc * ga[j][0][e]; y1[e] = xa[j][1][e] + o[j][4 + e] * sc * ga[j][1][e]; }
        yr[128 * j] = y0; yr[128 * j + 1] = y1; }
}
__device__ __forceinline__ void final_slices(const Frame& F, const Args& a, unsigned* ctl) {
    volatile LAS unsigned* bc = (volatile LAS unsigned*)(F.lds + MISC_OFF + 64);
    for (;;) {
        if (F.tid == 0) bc[0] = __hip_atomic_fetch_add(ctl + CW_FQ, 1u, __ATOMIC_RELAXED, __HIP_MEMORY_SCOPE_AGENT);
        __syncthreads();
        const unsigned idx = bc[0];
        if (idx >= (unsigned)(NPAN * 16)) break;
        const int q = (int)(idx >> 4), sl = (int)(idx & 15);
        const int pm = q;
        const bool split = (F.G == 256) && pm >= SPL_PM0 && pm < SPL_PM1;
        if (F.tid < 64) (void)panel_wait(ctl + CW_OD + 64 * pm, split ? 2 * NCT : NCT, ctl + CW_TMO);
        __syncthreads();
        final_row(F, a, pm * 256 + sl * 16 + F.wave * 2, split);
        final_row(F, a, pm * 256 + sl * 16 + F.wave * 2 + 1, split);
    }
}

__global__ void __launch_bounds__(NWAVES * 64, 2) hawk_fwd(Args args) {
    extern __shared__ __attribute__((aligned(16))) unsigned char lds[];
    Frame F;
    F.lds = (LAS unsigned char*)lds;
    F.tid = threadIdx.x; F.lane = F.tid & 63; F.wave = __builtin_amdgcn_readfirstlane(F.tid >> 6);
    F.G = gridDim.x; { const int bx = blockIdx.x; F.vcu = (F.G % 8 == 0) ? (bx % 8) * (F.G / 8) + bx / 8 : bx; }
    volatile LAS unsigned* MISC = (volatile LAS unsigned*)(F.lds + MISC_OFF);
    for (int u = F.tid; u < (LDS_BYTES - LDSCTL_OFF) / 4; u += NWAVES * 64) ((LAS unsigned*)(F.lds + LDSCTL_OFF))[u] = 0u;
    __syncthreads();
    unsigned* ctl = (unsigned*)(args.ws + WS_CTL);
    XcdBarrier bar; bar.bar = ctl + CW_BAR; bar.x = 0; bar.st = nullptr;
    if (N_LAUNCHES == 1) bar = xcd_barrier_post(ctl + CW_BAR, MISC + 8);
    const int lo = args.ph_lo, hi = args.ph_hi;
#define IN(k) (lo <= (k) && (k) < hi)
#define SEAM(k) do { if (N_LAUNCHES == 1 && IN(k) && IN((k) + 1)) xcd_barrier(bar); } while (0)
    unsigned char* ws = args.ws;

    if (IN(0)) REPS(0) { p0_prologue(F, args); SEAM(0); }
    if (IN(1)) REPS(1) {
        const int nU = (MROWS / 256) * (INW / 256), rs = (nU / F.G > 1) ? nU / F.G - 1 : 0, nDyn = nU - rs * F.G;
        volatile LAS unsigned* bc = (volatile LAS unsigned*)(F.lds + MISC_OFF + 64);
        {
            EpiIn E{ws};
            SchedPlain S{(const char*)(ws + WS_XN), (const char*)(ws + WS_WIN), DM, DM, MROWS / 256, INW / 256, DM / 64, F.G, (int)blockIdx.x, rs, ctl + CW_Q1, bc};
            gm::gemm_phase<true>(F.lds, DM, DM, S, E);
        }
        for (int idx = (int)bc[0];;) {
            __syncthreads();
            if (idx - nDyn >= SD_N) break;
            p0b_chunk(F, args, idx - nDyn);
            if (F.tid == 0) bc[0] = __hip_atomic_fetch_add(ctl + CW_Q1, 1u, __ATOMIC_RELAXED, __HIP_MEMORY_SCOPE_AGENT);
            __syncthreads();
            idx = (int)bc[0];
        }
        SEAM(1);
    }
    if (IN(2)) REPS(2) { p2_mixers(F, args); SEAM(2); }
    if (IN(3)) REPS(3) { p3_carry(F, args); SEAM(3); }
    if (IN(4)) REPS(4) {
        const int v = tail_slot((int)blockIdx.x, F.G);
        {
            SchedBranch S{(const char*)(ws + WS_OAB), (const char*)(ws + WS_WBR), F.G, v};
            EpiBranch E{ws, ctl};
            gm::gemm_phase<true>(F.lds, KBR, KBR, S, E);
        }
        {
            SchedOut S{(const char*)(ws + WS_XN), (const char*)(ws + WS_WOUT), F.G, v, ctl};
            EpiOut E{ws, ctl};
            gm::gemm_phase<true>(F.lds, DM, DM, S, E);
        }
        final_slices(F, args, ctl);
    }
#undef IN
#undef SEAM
}

extern "C" void kernel_launch(void* const* d_in, const int* in_sizes, int n_in, void* d_out, int out_size, void* d_ws, size_t ws_size, hipStream_t stream) {
    static int grid = 0;
    if (grid == 0) {
        if (n_in != 19 || (size_t)out_size != O_END || ws_size < WS_END) { fprintf(stderr, "kernel_launch: unexpected shapes (n_in %d, out %d, ws %zu)\n", n_in, out_size, ws_size); grid = -1; return; }
        int dev = 0, cus = 0;
        if (hipGetDevice(&dev) != hipSuccess || hipDeviceGetAttribute(&cus, hipDeviceAttributeMultiprocessorCount, dev) != hipSuccess) { grid = -1; return; }
        if (hipFuncSetAttribute((const void*)hawk_fwd, hipFuncAttributeMaxDynamicSharedMemorySize, LDS_BYTES) != hipSuccess) { fprintf(stderr, "kernel_launch: hipFuncSetAttribute failed\n"); grid = -1; return; }
        grid = cus;
    }
    if (grid < 0) return;
    (void)hipMemsetAsync((char*)d_ws + WS_CTL, 0, CTL_ZERO_BYTES, stream);
    Args a{};
    for (int i = 0; i < 19; ++i) a.in[i] = (const float*)d_in[i];
    a.out = (float*)d_out; a.ws = (unsigned char*)d_ws;
    if (N_LAUNCHES == 1) { a.ph_lo = 0; a.ph_hi = N_PHASES; hipLaunchKernelGGL(hawk_fwd, dim3(grid), dim3(NWAVES * 64), LDS_BYTES, stream, a); }
    else for (int p = 0; p < N_PHASES; ++p) { a.ph_lo = p; a.ph_hi = p + 1; hipLaunchKernelGGL(hawk_fwd, dim3(grid), dim3(NWAVES * 64), LDS_BYTES, stream, a); }
}
```

```cpp
#include <hip/hip_runtime.h>
#include <cstdio>
#include <cstdint>

#ifndef MK_N_LAUNCHES
#define MK_N_LAUNCHES 1
#endif
constexpr int N_LAUNCHES = MK_N_LAUNCHES;
#ifndef DUP_PHASE
#define DUP_PHASE -1
#endif
#define REPS(k) for (int rep_ = 0; rep_ < ((DUP_PHASE) == (k) ? 2 : 1); ++rep_)
constexpr int N_PHASES = 5;

#define LAS __attribute__((address_space(3)))
#define GAS __attribute__((address_space(1)))
typedef unsigned short bf16_t;
typedef short bf16x8 __attribute__((ext_vector_type(8)));
typedef float f32x4 __attribute__((ext_vector_type(4)));
typedef float f32x16 __attribute__((ext_vector_type(16)));
typedef unsigned u32x4 __attribute__((ext_vector_type(4)));
typedef int i32x4 __attribute__((ext_vector_type(4)));
typedef unsigned u32x2 __attribute__((ext_vector_type(2)));
typedef float f32x2_t __attribute__((ext_vector_type(2)));
typedef __bf16 bf16x2_t __attribute__((ext_vector_type(2)));

constexpr int DM = 4096, SEQ = 8192, DECB = 128, DECT = 4, MROWS = SEQ + DECB * DECT;
constexpr int NBLK = 16, BLK = 256;
constexpr int HD = 64, NH = 32, NKV = 8, AW = NH * HD, KVW = NKV * HD, WIN = 128;
constexpr int INW = 2 * DM + 2 * AW + 2 * KVW + 2 * DM;
constexpr int KBR = DM + AW;
constexpr float RMS_EPS = 1e-6f;
constexpr float LOG2E = 1.4426950408889634f;
constexpr float QSCALE = 0.125f * LOG2E;
static_assert(INW == 21504 && MROWS == 8704, "shapes");
constexpr size_t O_YP = 0, O_YS = (size_t)SEQ * DM, O_CP = O_YS + (size_t)DECB * DECT * DM, O_HP = O_CP + 3 * DM, O_KP = O_HP + DM, O_VP = O_KP + (size_t)WIN * KVW,
                 O_CS = O_VP + (size_t)WIN * KVW, O_HS = O_CS + (size_t)DECB * 3 * DM, O_KS = O_HS + (size_t)DECB * DM, O_VS = O_KS + (size_t)DECB * WIN * KVW, O_END = O_VS + (size_t)DECB * WIN * KVW;
static_assert(O_END == 54673408, "output size");

constexpr size_t MiB = 1u << 20;
constexpr size_t WS_CTL = 0, CTL_ZERO_BYTES = 128 * 1024;
constexpr size_t WS_WIN = 1 * MiB;
constexpr size_t WS_WBR = 169 * MiB;
constexpr size_t WS_WOUT = 217 * MiB;
constexpr size_t WS_WG = 249 * MiB;
constexpr size_t WS_XN = 253 * MiB;
constexpr size_t WS_XL = 321 * MiB, WS_GL = 389 * MiB;
constexpr size_t WS_Q = 457 * MiB;
constexpr size_t WS_K = 491 * MiB, WS_V = 500 * MiB;
constexpr size_t WS_GA = 509 * MiB;
constexpr size_t WS_MA = 543 * MiB, WS_MB = 611 * MiB;
constexpr size_t WS_HLOC = 679 * MiB, WS_ACUM = 747 * MiB;
constexpr size_t WS_OAB = 815 * MiB;
constexpr size_t WS_CARA = 917 * MiB, WS_CARH = 919 * MiB;
constexpr size_t WS_PSS = 921 * MiB;
constexpr size_t WS_VCT = 925 * MiB;
constexpr size_t WS_KC = 942 * MiB;
constexpr size_t WS_LC = 959 * MiB;
constexpr size_t WS_OF1 = 960 * MiB;
constexpr size_t WS_XN8 = 976 * MiB;
constexpr size_t WS_W8 = 1010 * MiB;
constexpr size_t WS_SX = 1074 * MiB, WS_SW = 1075 * MiB;
constexpr size_t WS_END = 1076 * MiB;
constexpr int NT8_GL = DM / 256, NT8_GA = AW / 256, NT8_S = NT8_GL + NT8_GA, NT8_Q = AW / 256, NT8_SQ = NT8_S + NT8_Q, NT8 = NT8_SQ + 2 * DM / 256;
static_assert(WS_WIN + (size_t)INW * DM * 2 <= WS_WBR && WS_WBR + (size_t)DM * KBR * 2 <= WS_WOUT && WS_WOUT + (size_t)DM * DM * 2 <= WS_WG && WS_XN + (size_t)MROWS * DM * 2 <= WS_XL, "ws map");
static_assert(WS_HLOC + (size_t)MROWS * DM * 4 <= WS_OAB && WS_OAB + (size_t)MROWS * KBR * 2 <= WS_CARA && WS_K + (size_t)MROWS * KVW * 2 <= WS_V && WS_V + (size_t)MROWS * KVW * 2 <= WS_GA, "ws map");
constexpr int CW_BAR = 4096;
constexpr int CW_TMO = 64;
constexpr int CW_BD = 8192, CW_OD = CW_BD + 64 * 64, CW_FQ = CW_OD + 64 * 64;
constexpr int CW_Q1 = CW_FQ + 64, CW_Q2 = CW_Q1 + 64, CW_Q3 = CW_Q2 + 64, CW_Q0 = CW_Q3 + 64;
static_assert((size_t)(CW_Q0 + 64) * 4 <= CTL_ZERO_BYTES && (size_t)(CW_BAR + 3456) * 4 <= CTL_ZERO_BYTES, "control words inside the zeroed region");
constexpr int GATE0 = 2 * DM + 2 * AW + 2 * KVW;
constexpr unsigned LB_SENT = 0xffffffffu;
constexpr int LRU_OT = 65536;
constexpr int NPAN = MROWS / 256, NCT = DM / 256;

constexpr int RING_BYTES = 131072, LDSCTL_OFF = RING_BYTES, MISC_OFF = LDSCTL_OFF + 320, LDS_BYTES = 147456;
constexpr int NWAVES = 8;

__device__ __forceinline__ float bf2f(unsigned b) { return __uint_as_float(b << 16); }
__device__ __forceinline__ float bflo(unsigned w) { return __uint_as_float(w << 16); }
__device__ __forceinline__ float bfhi(unsigned w) { return __uint_as_float(w & 0xffff0000u); }
__device__ __forceinline__ unsigned cvtpk(float lo, float hi) { f32x2_t v = {lo, hi}; bf16x2_t b = __builtin_convertvector(v, bf16x2_t); return __builtin_bit_cast(unsigned, b); }
__device__ __forceinline__ float sigmoidf_(float v) { return __builtin_amdgcn_rcpf(1.0f + __builtin_amdgcn_exp2f(-v * LOG2E)); }
__device__ __forceinline__ float wave_sum(float v) {
#pragma unroll
    for (int o = 1; o < 64; o <<= 1) v += __shfl_xor(v, o);
    return v;
}
#define LDS_WAIT() asm volatile("s_waitcnt lgkmcnt(0)" ::: "memory")
#define VM_WAIT() asm volatile("s_waitcnt vmcnt(0)" ::: "memory")

namespace gm {
constexpr int BM = 256, BK = 64, HALF = 128, HTB = HALF * BK * 2, STAGE_BYTES = 8 * HTB, NXCD = 8, WGM = 8;
__host__ __device__ __forceinline__ int lds_byte(int r, int c) { const int st = (r >> 4) * 2 + (c >> 5), rr = r & 15, cc = c & 31, ob = rr * 64 + cc * 2; return st * 1024 + (ob ^ (((ob >> 9) & 1) << 5)); }
__host__ __device__ __forceinline__ void stage_rc(int b, int& R, int& C) { const int st = b / 1024, sb = b % 1024, swz = sb ^ (((sb >> 9) & 1) << 5); R = (st >> 1) * 16 + swz / 64; C = (st & 1) * 32 + (swz % 64) / 2; }
__host__ __device__ __forceinline__ int perm32(int rho) { const int n = rho >> 4, i = rho & 15; return 8 * (i >> 2) + 4 * n + (i & 3); }

struct Unit { const char* A; const char* B; int nt; int pm, pn, part; };

__device__ __forceinline__ void tile_of(int L, int nM, int nN, int& pm, int& pn) {
    const int nwg = nM * nN; int wgid = L;
    { const int q = nwg / NXCD, r = nwg % NXCD, xcd = wgid % NXCD, off = wgid / NXCD; wgid = (xcd < r ? xcd * (q + 1) : r * (q + 1) + (xcd - r) * q) + off; }
    const int nig = WGM * nN, gid = wgid / nig, fm = gid * WGM, gsz = (nM - fm) < WGM ? (nM - fm) : WGM;
    pm = fm + ((wgid % nig) % gsz); pn = (wgid % nig) / gsz;
}

template <bool I8> __device__ __forceinline__ f32x4 mma16(bf16x8 b, bf16x8 a, f32x4 c) {
    if constexpr (I8) return __builtin_bit_cast(f32x4, __builtin_amdgcn_mfma_i32_16x16x64_i8(__builtin_bit_cast(i32x4, b), __builtin_bit_cast(i32x4, a), __builtin_bit_cast(i32x4, c), 0, 0, 0));
    else return __builtin_amdgcn_mfma_f32_16x16x32_bf16(b, a, c, 0, 0, 0);
}
template <bool PERM, bool I8, class Epi, class Sched>
__device__ __forceinline__ void gemm_phase(LAS unsigned char* lds, const int lda, const int ldb, const Sched& S, const Epi& E) {
    const int tid = threadIdx.x, wid = __builtin_amdgcn_readfirstlane(tid >> 6), lane = tid & 63, wr = wid >> 2, wc = wid & 3, fr = lane & 15, fq = lane >> 4;
    unsigned voffA[2], voffB[2];
#pragma unroll
    for (int i = 0; i < 2; ++i) { int R, C; stage_rc(tid * 16 + i * 8192, R, C); const int Rb = PERM ? ((R & ~31) + perm32(R & 31)) : R;
        voffA[i] = (unsigned)(R * lda + C) * 2u; voffB[i] = (unsigned)(Rb * ldb + C) * 2u; }
    const size_t kstep = (size_t)(BK * 2);
    const size_t hstepA = (size_t)HALF * lda * 2, hstepB = (size_t)HALF * ldb * 2;
    const unsigned ldsw = (unsigned)wid * 1024u;
    const int aoff = lds_byte(wr * 64 + fr, fq * 8), boff = lds_byte(wc * 32 + fr, fq * 8);
#define PG8_SA(b, h) (((b) * 2 + (h)) * HTB)
#define PG8_SB(b, h) ((4 + (b) * 2 + (h)) * HTB)
#define PG8_STAGE(bufoff, gbase, voff) do { _Pragma("unroll") for (int _i = 0; _i < 2; ++_i) \
        __builtin_amdgcn_global_load_lds((const unsigned*)((const char*)(gbase) + (voff)[_i]), (LAS unsigned*)(lds + (bufoff) + ldsw + _i * 8192), 16, 0, 0); } while (0)
#define PG8_LDA(dst, b, h) do { _Pragma("unroll") for (int m = 0; m < 4; ++m) _Pragma("unroll") for (int k = 0; k < 2; ++k) dst[m][k] = *(const LAS bf16x8*)(lds + PG8_SA(b, h) + aoff + m * 2048 + k * 1024); } while (0)
#define PG8_LDB(dst, b, h) do { _Pragma("unroll") for (int n = 0; n < 2; ++n) _Pragma("unroll") for (int k = 0; k < 2; ++k) dst[n][k] = *(const LAS bf16x8*)(lds + PG8_SB(b, h) + boff + n * 2048 + k * 1024); } while (0)
#define PG8_MMA(ai, bj, At, Bt) do { __builtin_amdgcn_s_setprio(1); _Pragma("unroll") for (int m = 0; m < 4; ++m) _Pragma("unroll") for (int n = 0; n < 2; ++n) _Pragma("unroll") for (int k = 0; k < 2; ++k) \
        acc[ai][bj][m][n] = mma16<I8>(Bt[n][k], At[m][k], acc[ai][bj][m][n]); __builtin_amdgcn_s_setprio(0); } while (0)
#define PG8_WAIT_V(n) asm volatile("s_waitcnt vmcnt(" #n ")" ::: "memory")
#define PG8_WAIT_L(n) asm volatile("s_waitcnt lgkmcnt(" #n ")" ::: "memory")
#define PG8_BAR __builtin_amdgcn_s_barrier()
#define PG8_SCHED __builtin_amdgcn_sched_barrier(0)
    Unit cur, nxt; int ui = 0;
    if (!S.next(0, cur)) return;
    f32x4 acc[2][2][4][2];
#pragma unroll
    for (int a = 0; a < 2; ++a)
#pragma unroll
        for (int b = 0; b < 2; ++b)
#pragma unroll
            for (int m = 0; m < 4; ++m)
#pragma unroll
                for (int n = 0; n < 2; ++n) acc[a][b][m][n] = (f32x4){0.f, 0.f, 0.f, 0.f};
    bf16x8 At[4][2], B0[2][2], B1[2][2];
    const char* cA = cur.A; const char* cB = cur.B;
    S.a_ready(cur);
    PG8_STAGE(PG8_SB(0, 0), cB, voffB); PG8_STAGE(PG8_SB(0, 1), cB + hstepB, voffB); PG8_STAGE(PG8_SA(0, 0), cA, voffA); PG8_STAGE(PG8_SA(0, 1), cA + hstepA, voffA);
    if (wr == 1) PG8_BAR;
    PG8_WAIT_V(2); PG8_BAR;
    PG8_STAGE(PG8_SB(1, 0), cB + kstep, voffB); PG8_STAGE(PG8_SA(1, 0), cA + kstep, voffA); PG8_STAGE(PG8_SB(1, 1), cB + hstepB + kstep, voffB);
    PG8_WAIT_V(6); PG8_BAR;
    for (;;) {
        const bool has_next = S.next(ui + 1, nxt);
        const char* nA = has_next ? nxt.A : cA; const char* nB = has_next ? nxt.B : cB;
        const int nt = cur.nt;
        for (int t = 0; t < nt; t += 2) {
            const bool last = (t == nt - 2);
            const char* a1 = cA + (size_t)(t + 1) * kstep;
            const char* a2 = last ? nA : cA + (size_t)(t + 2) * kstep; const char* b2 = last ? nB : cB + (size_t)(t + 2) * kstep;
            const char* a3 = a2 + kstep; const char* b3 = b2 + kstep;
            if (last && has_next) S.a_ready(nxt);
            PG8_LDB(B0, 0, 0); PG8_LDB(B1, 0, 1); PG8_SCHED; PG8_LDA(At, 0, 0); PG8_STAGE(PG8_SA(1, 1), a1 + hstepA, voffA);
            PG8_WAIT_V(8); PG8_WAIT_L(0); PG8_BAR; PG8_MMA(0, 0, At, B0); PG8_MMA(0, 1, At, B1); PG8_BAR; PG8_SCHED;
            PG8_LDA(At, 0, 1); PG8_STAGE(PG8_SB(0, 0), b2, voffB); PG8_STAGE(PG8_SB(0, 1), b2 + hstepB, voffB); PG8_STAGE(PG8_SA(0, 0), a2, voffA);
            PG8_WAIT_V(8); PG8_WAIT_L(0); PG8_BAR; PG8_MMA(1, 0, At, B0); PG8_MMA(1, 1, At, B1); PG8_BAR; PG8_SCHED;
            PG8_LDB(B0, 1, 0); PG8_LDB(B1, 1, 1); PG8_SCHED; PG8_LDA(At, 1, 0); PG8_STAGE(PG8_SA(0, 1), a2 + hstepA, voffA);
            PG8_WAIT_V(8); PG8_WAIT_L(0); PG8_BAR; PG8_MMA(0, 0, At, B0); PG8_MMA(0, 1, At, B1); PG8_BAR; PG8_SCHED;
            PG8_LDA(At, 1, 1); PG8_STAGE(PG8_SB(1, 0), b3, voffB); PG8_STAGE(PG8_SB(1, 1), b3 + hstepB, voffB); PG8_STAGE(PG8_SA(1, 0), a3, voffA);
            PG8_WAIT_V(8); PG8_WAIT_L(0); PG8_BAR; PG8_MMA(1, 0, At, B0); PG8_MMA(1, 1, At, B1); PG8_BAR; PG8_SCHED;
        }
        if (wr == 0) PG8_BAR;
        const bool keep = E(acc, cur, wr, wc, fr, fq);
        if (!has_next) break;
        if (!keep) {
#pragma unroll
            for (int a = 0; a < 2; ++a)
#pragma unroll
                for (int b = 0; b < 2; ++b)
#pragma unroll
                    for (int m = 0; m < 4; ++m)
#pragma unroll
                        for (int n = 0; n < 2; ++n) acc[a][b][m][n] = (f32x4){0.f, 0.f, 0.f, 0.f};
        }
        cur = nxt; cA = nA; cB = nB; ++ui;
        if (wr == 1) PG8_BAR;
    }
    PG8_WAIT_V(0);
    PG8_BAR;
#undef PG8_SA
#undef PG8_SB
#undef PG8_STAGE
#undef PG8_LDA
#undef PG8_LDB
#undef PG8_MMA
#undef PG8_WAIT_V
#undef PG8_WAIT_L
#undef PG8_BAR
#undef PG8_SCHED
}
}

#define XB_TMO      128
#define XB_XCNT(j)  (256  + 64 * (j))
#define XB_XSUB(j)  (1280 + 64 * (j))
#define XB_XGEN(j)  (2304 + 64 * (j))
#define XB_TOP      3328
#define XB_TOPGEN   3392
#define XCD_BAR_WORDS 3456
#define XB_SPIN_CAP (1u << 20)
__device__ __forceinline__ unsigned xb_ld(unsigned* p)              { return __hip_atomic_load(p, __ATOMIC_RELAXED, __HIP_MEMORY_SCOPE_AGENT); }
__device__ __forceinline__ unsigned xb_add(unsigned* p, unsigned v) { return __hip_atomic_fetch_add(p, v, __ATOMIC_RELAXED, __HIP_MEMORY_SCOPE_AGENT); }
__device__ __forceinline__ unsigned xb_xcc_id() { return (unsigned)__builtin_amdgcn_s_getreg((3 << 11) | 20) & 0xFu; }
#define XB_SPIN(cond, bar) do { unsigned _sp = 0; while (cond) { __builtin_amdgcn_s_sleep(1); \
    if ((++_sp & 255u) == 0u) { if (xb_ld(&(bar)[XB_TMO])) break; if (_sp > XB_SPIN_CAP) { atomicAdd(&(bar)[XB_TMO], 1u); break; } } } } while (0)
struct XcdBarrier { unsigned* bar; unsigned x; volatile LAS unsigned* st; };
__device__ __forceinline__ XcdBarrier xcd_barrier_post(unsigned* bar, volatile LAS unsigned* st) {
    XcdBarrier b; b.bar = bar; b.x = xb_xcc_id(); b.st = st;
    if (threadIdx.x == 0) (void)xb_add(&bar[XB_XCNT(b.x)], 1u);
    return b;
}
__device__ __forceinline__ void xcd_barrier_complete(unsigned* bar, unsigned x, unsigned& nloc, unsigned& nx) {
    const unsigned G = gridDim.x * gridDim.y * gridDim.z;
    unsigned sum, cnt, mine, sp = 0u;
    for (;;) {
        sum = 0u; cnt = 0u; mine = 0u;
#pragma unroll
        for (unsigned j = 0; j < 16; ++j) { const unsigned c = xb_ld(&bar[XB_XCNT(j)]); sum += c; cnt += (c > 0u) ? 1u : 0u; mine = (j == x) ? c : mine; }
        if (sum == G) break;
        __builtin_amdgcn_s_sleep(1);
        if ((++sp & 255u) == 0u) { if (xb_ld(&bar[XB_TMO])) break; if (sp > XB_SPIN_CAP) { atomicAdd(&bar[XB_TMO], 1u); break; } }
    }
    nloc = mine > 0u ? mine : 1u; nx = cnt > 0u ? cnt : 1u;
}
__device__ __forceinline__ void xcd_barrier(const XcdBarrier& b) {
    asm volatile("s_waitcnt vmcnt(0)" ::: "memory");
    __syncthreads();
    if (threadIdx.x == 0) {
        unsigned* bar = b.bar;
        __builtin_amdgcn_s_waitcnt(0);
        unsigned nloc = b.st[0], nx = b.st[1];
        if (nloc == 0u) { xcd_barrier_complete(bar, b.x, nloc, nx); b.st[0] = nloc; b.st[1] = nx; }
        const unsigned old = xb_add(&bar[XB_XSUB(b.x)], 1u);
        const unsigned gen = old / nloc;
        if (old + 1u == (gen + 1u) * nloc) {
            __builtin_amdgcn_fence(__ATOMIC_RELEASE, "agent");
            asm volatile("s_waitcnt vmcnt(0)" ::: "memory");
            const unsigned og = xb_add(&bar[XB_TOP], 1u);
            const unsigned tg = og / nx;
            if (og + 1u == (tg + 1u) * nx) xb_add(&bar[XB_TOPGEN], 1u);
            else XB_SPIN(xb_ld(&bar[XB_TOPGEN]) == tg, bar);
            __builtin_amdgcn_fence(__ATOMIC_ACQUIRE, "agent");
            xb_add(&bar[XB_XGEN(b.x)], 1u);
            asm volatile("s_waitcnt vmcnt(0)" ::: "memory");
        } else {
            XB_SPIN(xb_ld(&bar[XB_XGEN(b.x)]) == gen, bar);
            __builtin_amdgcn_fence(__ATOMIC_ACQUIRE, "agent");
            asm volatile("s_waitcnt vmcnt(0)" ::: "memory");
        }
    }
    __syncthreads();
}

struct Args { const float* in[19]; float* out; unsigned char* ws; int ph_lo, ph_hi; };
enum { I_XP = 0, I_XS, I_SCONV, I_SH, I_CK, I_CV, I_NPRE, I_NPOST, I_WIN, I_CONVW, I_CONVB, I_WA, I_BA, I_WX, I_BX, I_LAM, I_SINK, I_WBR, I_WOUT };

struct Frame {
    LAS unsigned char* lds;
    int tid, lane, wave, vcu, G;
};

template <bool REMAP = false>
__device__ __forceinline__ void p0_transpose_item(const float* W, int K, int N, bf16_t* WT, LAS float* scr, int item, int lane) {
    const int nblk = N / 32, kb = item / nblk, nb = item % nblk, k0 = 64 * kb; int n0 = 32 * nb;
#pragma unroll 8
    for (int i = 0; i < 32; ++i) { const int kk = 2 * i + (lane >> 5); scr[kk * 33 + (lane & 31)] = W[(size_t)(k0 + kk) * N + n0 + (lane & 31)]; }
    LDS_WAIT(); asm volatile("" ::: "memory");
    const int c = lane & 7;
    int d0 = n0;
    if (REMAP && n0 >= 2 * DM + 2 * AW + 2 * KVW) { const int j = n0 - (2 * DM + 2 * AW + 2 * KVW), half = j >= DM, jj = half ? j - DM : j; d0 = (2 * DM + 2 * AW + 2 * KVW) + (jj >> 7) * 256 + half * 128 + (jj & 127); }
#pragma unroll
    for (int j = 0; j < 4; ++j) { const int n = (lane >> 3) + 8 * j; const LAS float* s = scr + (8 * c) * 33 + n;
        u32x4 o; o.x = cvtpk(s[0 * 33], s[1 * 33]); o.y = cvtpk(s[2 * 33], s[3 * 33]); o.z = cvtpk(s[4 * 33], s[5 * 33]); o.w = cvtpk(s[6 * 33], s[7 * 33]);
        *(GAS u32x4*)(WT + (size_t)(d0 + n) * K + k0 + 8 * c) = o; }
    LDS_WAIT(); asm volatile("" ::: "memory");
}

constexpr int GI_N = (NT8 * 256) / 32, GI_PITCH = DM + 16;
__device__ __forceinline__ void p0_gate_item(const Frame& F, const Args& a, int it) {
    unsigned char* ws = a.ws;
    int tid = threadIdx.x; asm volatile("" : "+v"(tid));
    const int cq = tid & 7, kb = tid >> 3;
    int n0, r0;
    if (it < NT8_GL * 8) { n0 = DM + 32 * it; r0 = 32 * it; }
    else if (it < NT8_S * 8) { n0 = 2 * DM + AW + 2 * KVW + 32 * (it - NT8_GL * 8); r0 = 32 * it; }
    else if (it < NT8_SQ * 8) { n0 = 2 * DM + 32 * (it - NT8_S * 8); r0 = 32 * it; }
    else { const int j = 32 * (it - NT8_SQ * 8), half = j >= DM, jj = j & (DM - 1); n0 = GATE0 + j; r0 = NT8_SQ * 256 + (jj >> 7) * 256 + half * 128 + (jj & 127); }
    const unsigned voff = (unsigned)((8 * kb) * INW + 4 * cq) * 4u;
    const char* sbase = (const char*)(a.in[I_WIN] + n0);
#define GI_LD(dst, p, i) do { const char* sp_ = sbase + (size_t)(512 * (p)) * INW * 4; asm volatile("" : "+s"(sp_)); \
        asm volatile("global_load_dwordx4 %0, %1, %2" : "=v"(dst) : "v"(voff), "s"(sp_ + (size_t)(i) * INW * 4) : "memory"); } while (0)
    unsigned pk[8][4][4]; float mx[4] = {0.f, 0.f, 0.f, 0.f};
#pragma unroll
    for (int p = 0; p < 8; ++p)
#pragma unroll
        for (int hs = 0; hs < 2; ++hs) {
            f32x4 va[4];
#pragma unroll
            for (int i = 0; i < 4; ++i) GI_LD(va[i], p, 4 * hs + i);
            asm volatile("s_waitcnt vmcnt(0)" ::: "memory");
            asm volatile("" : "+v"(va[0]), "+v"(va[1]), "+v"(va[2]), "+v"(va[3]) :: "memory");
#pragma unroll
            for (int e = 0; e < 4; ++e)
#pragma unroll
                for (int pr = 0; pr < 2; ++pr) { const unsigned w = cvtpk(va[2 * pr][e], va[2 * pr + 1][e]); pk[p][e][2 * hs + pr] = w; mx[e] = fmaxf(mx[e], fmaxf(fabsf(bflo(w)), fabsf(bfhi(w)))); }
            asm volatile("" : "+v"(pk[p][0][2 * hs]), "+v"(pk[p][0][2 * hs + 1]), "+v"(pk[p][1][2 * hs]), "+v"(pk[p][1][2 * hs + 1]),
                              "+v"(pk[p][2][2 * hs]), "+v"(pk[p][2][2 * hs + 1]), "+v"(pk[p][3][2 * hs]), "+v"(pk[p][3][2 * hs + 1]) :: "memory");
        }
#undef GI_LD
    LAS unsigned char* T = F.lds; LAS float* red = (LAS float*)(F.lds + 16 * GI_PITCH);
#pragma unroll
    for (int e = 0; e < 4; ++e) {
#pragma unroll
        for (int o = 8; o < 64; o <<= 1) mx[e] = fmaxf(mx[e], __shfl_xor(mx[e], o));
        if ((tid & 63) < 8) red[F.wave * 32 + 4 * cq + e] = mx[e]; }
    __syncthreads();
    float inv[4];
#pragma unroll
    for (int e = 0; e < 4; ++e) { float m = 0.f;
#pragma unroll
        for (int w = 0; w < NWAVES; ++w) m = fmaxf(m, red[w * 32 + 4 * cq + e]);
        inv[e] = m > 0.f ? 127.0f / m : 0.f;
        if (tid < 8) ((float*)(ws + WS_SW))[r0 + 4 * cq + e] = m * (1.0f / 127.0f); }
    u32x2 qk[8][4];
#pragma unroll
    for (int p = 0; p < 8; ++p) {
#pragma unroll
        for (int e = 0; e < 4; ++e) { unsigned q[8];
#pragma unroll
            for (int pr = 0; pr < 4; ++pr) { q[2 * pr] = (unsigned)(int)__builtin_rintf(bflo(pk[p][e][pr]) * inv[e]) & 255u; q[2 * pr + 1] = (unsigned)(int)__builtin_rintf(bfhi(pk[p][e][pr]) * inv[e]) & 255u; }
            qk[p][e].x = q[0] | (q[1] << 8) | (q[2] << 16) | (q[3] << 24); qk[p][e].y = q[4] | (q[5] << 8) | (q[6] << 16) | (q[7] << 24); }
        __builtin_amdgcn_sched_barrier(0);
    }
#pragma unroll
    for (int hh = 0; hh < 2; ++hh) {
        if ((cq >> 2) == hh) {
#pragma unroll
            for (int p = 0; p < 8; ++p)
#pragma unroll
                for (int e = 0; e < 4; ++e) *(LAS u32x2*)(T + (4 * (cq & 3) + e) * GI_PITCH + 512 * p + 8 * kb) = qk[p][e];
        }
        __syncthreads();
#pragma unroll
        for (int ps = 0; ps < 8; ++ps) { const int row = 2 * ps + (tid >> 8), off = (tid & 255) * 16;
            const u32x4 v = *(const LAS u32x4*)(T + row * GI_PITCH + off);
            *(GAS u32x4*)(ws + WS_W8 + (size_t)(r0 + 16 * hh + row) * DM + off) = v; }
        __syncthreads();
    }
}

__device__ __forceinline__ void p0_prologue(const Frame& F0, const Args& a, unsigned* ctl) {
    unsigned char* ws = a.ws;
    LAS float* scr = (LAS float*)(F0.lds + F0.wave * 16384);
    const int gw = F0.vcu * NWAVES + F0.wave, NGW = F0.G * NWAVES;
    for (int it = F0.vcu; it < GI_N; it += F0.G) p0_gate_item(F0, a, it);
    Frame F = F0; { int t_ = threadIdx.x; asm volatile("" : "+v"(t_)); F.tid = t_; F.lane = t_ & 63; }
    {
        constexpr int NBB = (DM + 2 * KVW) / 32, I_IN = (DM / 64) * NBB, I_G = NBLK * (BLK / 64) * (BLK / 32), NCH = (I_IN + 2 * I_G) / 64;
        static_assert((I_IN + 2 * I_G) % 64 == 0, "P0 chunks");
        volatile LAS unsigned* bc = (volatile LAS unsigned*)(F.lds + MISC_OFF + 64);
        for (;;) {
            if (F.tid == 0) bc[0] = __hip_atomic_fetch_add(ctl + CW_Q0, 1u, __ATOMIC_RELAXED, __HIP_MEMORY_SCOPE_AGENT);
            __syncthreads();
            const int ch = (int)bc[0];
            __syncthreads();
            if (ch >= NCH) break;
#pragma unroll 1
            for (int k = 0; k < 8; ++k) {
                int r = ch * 64 + k * NWAVES + F.wave;
                if (r < I_IN) { const int kb = r / NBB, q = r % NBB, nb = q < DM / 32 ? q : (2 * DM + AW) / 32 + (q - DM / 32);
                    p0_transpose_item(a.in[I_WIN], DM, INW, (bf16_t*)(ws + WS_WIN), scr, kb * (INW / 32) + nb, F.lane); continue; } r -= I_IN;
                const int gate = r >= I_G; if (gate) r -= I_G;
                const int blk = r / ((BLK / 64) * (BLK / 32)), sub = r % ((BLK / 64) * (BLK / 32));
                p0_transpose_item(a.in[gate ? I_WX : I_WA] + (size_t)blk * BLK * BLK, BLK, BLK, (bf16_t*)(ws + WS_WG) + (size_t)(blk * 2 + gate) * BLK * BLK, scr, sub, F.lane);
            }
        }
        __syncthreads();
    }
    for (int i = gw * 64 + F.lane; i < (SEQ / 128) * DM / 4; i += NGW * 64) { const u32x4 sv = {LB_SENT, LB_SENT, LB_SENT, LB_SENT};
        ((u32x4*)(ws + WS_CARA))[i] = sv; ((u32x4*)(ws + WS_CARH))[i] = sv; ((u32x4*)(ws + WS_PSS))[i] = sv; }
    for (int ch = gw * 64 + F.lane; ch < DM; ch += NGW * 64) {
        float* lc = (float*)(ws + WS_LC);
        lc[ch] = -a.in[I_BA][ch] * LOG2E; lc[DM + ch] = -a.in[I_BX][ch] * LOG2E; lc[2 * DM + ch] = -8.0f * LOG2E * log1pf(expf(-a.in[I_LAM][ch]));
    }
    {
        const GAS f32x4* gp = (const GAS f32x4*)a.in[I_NPRE] + F.lane; asm volatile("" : "+v"(gp));
        bf16_t* XN = (bf16_t*)(ws + WS_XN);
        f32x4 g[16];
#pragma unroll
        for (int j = 0; j < 16; ++j) g[j] = gp[64 * j];
        f32x4 v[16], w[16];
        int m = gw;
        if (m < MROWS) { const float* xrow = (m < SEQ) ? a.in[I_XP] + (size_t)m * DM : a.in[I_XS] + (size_t)(m - SEQ) * DM;
#pragma unroll
            for (int j = 0; j < 16; ++j) v[j] = ((const GAS f32x4*)xrow + F.lane)[64 * j]; }
        for (; m < MROWS; m += NGW) {
            const int mn = m + NGW;
            if (mn < MROWS) { const float* xrow = (mn < SEQ) ? a.in[I_XP] + (size_t)mn * DM : a.in[I_XS] + (size_t)(mn - SEQ) * DM;
#pragma unroll
                for (int j = 0; j < 16; ++j) w[j] = ((const GAS f32x4*)xrow + F.lane)[64 * j]; }
            float s = 0.f;
#pragma unroll
            for (int j = 0; j < 16; ++j) s += (v[j].x * v[j].x + v[j].y * v[j].y) + (v[j].z * v[j].z + v[j].w * v[j].w);
            const float sc = 1.0f / sqrtf(wave_sum(s) * (1.0f / DM) + RMS_EPS);
            GAS u32x2* o8 = (GAS u32x2*)(XN + (size_t)m * DM) + F.lane;
            float amax = 0.f;
#pragma unroll
            for (int j = 0; j < 16; ++j) { const float t0 = v[j].x * sc * g[j].x, t1 = v[j].y * sc * g[j].y, t2 = v[j].z * sc * g[j].z, t3 = v[j].w * sc * g[j].w;
                amax = fmaxf(fmaxf(amax, fmaxf(fabsf(t0), fabsf(t1))), fmaxf(fabsf(t2), fabsf(t3)));
                u32x2 o; o.x = cvtpk(t0, t1); o.y = cvtpk(t2, t3); o8[64 * j] = o; }
#pragma unroll
            for (int o = 1; o < 64; o <<= 1) amax = fmaxf(amax, __shfl_xor(amax, o));
            const float qi = amax > 0.f ? 127.0f / amax : 0.f;
            GAS unsigned* o4 = (GAS unsigned*)(ws + WS_XN8 + (size_t)m * DM) + F.lane;
#pragma unroll
            for (int j = 0; j < 16; ++j) { const float t0 = v[j].x * sc * g[j].x, t1 = v[j].y * sc * g[j].y, t2 = v[j].z * sc * g[j].z, t3 = v[j].w * sc * g[j].w;
                o4[64 * j] = ((unsigned)(int)__builtin_rintf(t0 * qi) & 255u) | (((unsigned)(int)__builtin_rintf(t1 * qi) & 255u) << 8) | (((unsigned)(int)__builtin_rintf(t2 * qi) & 255u) << 16) | ((unsigned)(int)__builtin_rintf(t3 * qi) << 24); }
            if (F.lane == 0) ((float*)(ws + WS_SX))[m] = amax * (1.0f / 127.0f);
#pragma unroll
            for (int j = 0; j < 16; ++j) v[j] = w[j];
        }
    }
}
__device__ __forceinline__ void p0_quant(const Frame& F, const Args& a) {
    const int gw = F.vcu * NWAVES + F.wave, NGW = F.G * NWAVES;
    const bf16_t* WT = (const bf16_t*)(a.ws + WS_WIN);
    float* SW = (float*)(a.ws + WS_SW);
    auto src_row = [](int r) { return r < NT8_GL * 256 ? DM + r : r < NT8_S * 256 ? (2 * DM + AW + 2 * KVW) + (r - NT8_GL * 256) : GATE0 + (r - NT8_S * 256); };
    for (int r0 = gw; r0 < NT8 * 256; r0 += 2 * NGW) {
        const int r1 = r0 + NGW; const bool two = r1 < NT8 * 256; const int r1c = two ? r1 : r0;
        u32x4 v[2][8];
#pragma unroll
        for (int j = 0; j < 8; ++j) { v[0][j] = ((const GAS u32x4*)(WT + (size_t)src_row(r0) * DM) + F.lane)[64 * j]; v[1][j] = ((const GAS u32x4*)(WT + (size_t)src_row(r1c) * DM) + F.lane)[64 * j]; }
#pragma unroll
        for (int h = 0; h < 2; ++h) {
            float amax = 0.f;
#pragma unroll
            for (int j = 0; j < 8; ++j)
#pragma unroll
                for (int e = 0; e < 4; ++e) amax = fmaxf(amax, fmaxf(fabsf(bflo(v[h][j][e])), fabsf(bfhi(v[h][j][e]))));
#pragma unroll
            for (int o = 1; o < 64; o <<= 1) amax = fmaxf(amax, __shfl_xor(amax, o));
            const float qi = amax > 0.f ? 127.0f / amax : 0.f;
            const int r = h ? r1c : r0;
            GAS u32x2* dst = (GAS u32x2*)(a.ws + WS_W8 + (size_t)r * DM) + F.lane;
            if (h == 0 || two) {
#pragma unroll
                for (int j = 0; j < 8; ++j) { unsigned q[8];
#pragma unroll
                    for (int e = 0; e < 4; ++e) { q[2 * e] = (unsigned)(int)__builtin_rintf(bflo(v[h][j][e]) * qi) & 255u; q[2 * e + 1] = (unsigned)(int)__builtin_rintf(bfhi(v[h][j][e]) * qi) & 255u; }
                    u32x2 o; o.x = q[0] | (q[1] << 8) | (q[2] << 16) | (q[3] << 24); o.y = q[4] | (q[5] << 8) | (q[6] << 16) | (q[7] << 24); dst[64 * j] = o; }
                if (F.lane == 0) SW[r] = amax * (1.0f / 127.0f);
            }
        }
    }
}
constexpr int SD_T = ((KBR / 64) * (DM / 32) + (DM / 64) * (DM / 32) + DECB * (WIN / 64) * (KVW / 32)) / 64, SD_K = DECB * 4 / NWAVES, SD_S = 2 * DECB * 4 / NWAVES, SD_N = SD_T + SD_K + SD_S;
__device__ __forceinline__ void p0b_chunk(const Frame& F, const Args& a, int ch) {
    unsigned char* ws = a.ws;
    if (ch < SD_T) {
        LAS float* scr = (LAS float*)(F.lds + F.wave * 16384);
        constexpr int I_BR = (KBR / 64) * (DM / 32), I_OUT = (DM / 64) * (DM / 32);
#pragma unroll 1
        for (int k = 0; k < 8; ++k) {
            int r = ch * 64 + k * NWAVES + F.wave;
            if (r < I_BR) { p0_transpose_item(a.in[I_WBR], KBR, DM, (bf16_t*)(ws + WS_WBR), scr, r, F.lane); continue; } r -= I_BR;
            if (r < I_OUT) { p0_transpose_item(a.in[I_WOUT], DM, DM, (bf16_t*)(ws + WS_WOUT), scr, r, F.lane); continue; } r -= I_OUT;
            const int b = r / ((WIN / 64) * (KVW / 32)), sub = r % ((WIN / 64) * (KVW / 32));
            p0_transpose_item(a.in[I_CV] + (size_t)b * WIN * KVW, WIN, KVW, (bf16_t*)(ws + WS_VCT) + (size_t)b * WIN * KVW, scr, sub, F.lane);
        }
        return;
    }
    ch -= SD_T;
    if (ch < SD_K) {
        const int it = ch * NWAVES + F.wave;
        const GAS f32x4* src = (const GAS f32x4*)(a.in[I_CK] + (size_t)it * 32 * KVW) + F.lane;
        GAS u32x2* dst = (GAS u32x2*)((bf16_t*)(ws + WS_KC) + (size_t)it * 32 * KVW) + F.lane;
#pragma unroll 1
        for (int i0 = 0; i0 < 64; i0 += 8) { f32x4 v[8];
#pragma unroll
            for (int i = 0; i < 8; ++i) v[i] = src[64 * (i0 + i)];
#pragma unroll
            for (int i = 0; i < 8; ++i) { u32x2 o; o.x = cvtpk(v[i].x, v[i].y); o.y = cvtpk(v[i].z, v[i].w); dst[64 * (i0 + i)] = o; } }
        return;
    }
    ch -= SD_K;
    {
        const int it = ch * NWAVES + F.wave, kv = it / (DECB * 4), b = (it / 4) % DECB, qd = it % 4;
        const GAS f32x4* src = (const GAS f32x4*)(a.in[kv ? I_CV : I_CK] + (size_t)b * WIN * KVW + (size_t)(4 + 31 * qd) * KVW) + F.lane;
        GAS f32x4* dst = (GAS f32x4*)(a.out + (kv ? O_VS : O_KS) + (size_t)b * WIN * KVW + (size_t)(31 * qd) * KVW) + F.lane;
#pragma unroll 1
        for (int i0 = 0; i0 < 56; i0 += 8) { f32x4 v[8];
#pragma unroll
            for (int i = 0; i < 8; ++i) v[i] = src[64 * (i0 + i)];
#pragma unroll
            for (int i = 0; i < 8; ++i) dst[64 * (i0 + i)] = v[i]; }
        { f32x4 v[6];
#pragma unroll
            for (int i = 0; i < 6; ++i) v[i] = src[64 * (56 + i)];
#pragma unroll
            for (int i = 0; i < 6; ++i) dst[64 * (56 + i)] = v[i]; }
    }
}

struct SchedPlain {
    const char* A; const char* Bt; int lda, ldb, nM, nN, nt, G, c, rs; unsigned* q; volatile LAS unsigned* bc; int skip_lo, skip_n;
    __device__ __forceinline__ bool next(int i, gm::Unit& u) const {
        long L;
        if (i < rs) L = (long)i * G + c;
        else {
            if (threadIdx.x == 0) bc[0] = __hip_atomic_fetch_add(q, 1u, __ATOMIC_RELAXED, __HIP_MEMORY_SCOPE_AGENT);
            asm volatile("s_waitcnt lgkmcnt(0)" ::: "memory"); __builtin_amdgcn_s_barrier(); asm volatile("" ::: "memory");
            L = (long)rs * G + (long)bc[0];
        }
        if (L >= (long)nM * nN) return false;
        gm::tile_of((int)L, nM, nN, u.pm, u.pn); u.part = 0; u.nt = nt; if (u.pn >= skip_lo) u.pn += skip_n;
        u.A = A + (size_t)u.pm * 256 * lda * 2; u.B = Bt + (size_t)u.pn * 256 * ldb * 2; return true;
    }
    __device__ __forceinline__ void a_ready(const gm::Unit&) const {}
};
__device__ __forceinline__ int tail_slot(int bx, int G) {
    if (G != 256) return bx;
    const int x = bx & 7, k = bx >> 3; return (x >> 1) * 64 + (k & 3) * 16 + (x & 1) * 8 + (k >> 2);
}
__device__ __forceinline__ bool panel_wait(unsigned* cnt, unsigned need, unsigned* tmo) {
    unsigned sp = 0; bool ok = true;
    while ((unsigned)__builtin_amdgcn_readfirstlane(__hip_atomic_load(cnt, __ATOMIC_RELAXED, __HIP_MEMORY_SCOPE_AGENT)) < need) {
        __builtin_amdgcn_s_sleep(2);
        if ((++sp & 255u) == 0u) { if (__hip_atomic_load(tmo, __ATOMIC_RELAXED, __HIP_MEMORY_SCOPE_AGENT)) { ok = false; break; }
            if (sp > (1u << 20)) { __hip_atomic_store(tmo, 1u, __ATOMIC_RELAXED, __HIP_MEMORY_SCOPE_AGENT); ok = false; break; } }
    }
    __builtin_amdgcn_fence(__ATOMIC_ACQUIRE, "agent");
    asm volatile("s_waitcnt vmcnt(0)" ::: "memory");
    return ok;
}
__device__ __forceinline__ void panel_signal(unsigned* cnt) {
    asm volatile("s_waitcnt vmcnt(0)" ::: "memory");
    __builtin_amdgcn_s_barrier();
    if (threadIdx.x == 0) __hip_atomic_fetch_add(cnt, 1u, __ATOMIC_RELAXED, __HIP_MEMORY_SCOPE_AGENT);
}
__device__ __forceinline__ void store16_wt(__amdgpu_buffer_rsrc_t rs, size_t byte_off, u32x4 v) { __builtin_amdgcn_raw_buffer_store_b128(v, rs, (int)byte_off, 0, 16); }
struct SchedBranch {
    const char* A; const char* Bt; int G, v;
    __device__ __forceinline__ bool next(int i, gm::Unit& u) const {
        const int L = (i >> 1) * G + v; if (L >= NPAN * NCT) return false;
        u.pm = L / NCT; u.pn = L % NCT; u.part = i & 1; u.nt = u.part ? AW / 64 : DM / 64;
        const size_t koff = u.part ? (size_t)DM * 2 : 0;
        u.A = A + (size_t)u.pm * 256 * KBR * 2 + koff; u.B = Bt + (size_t)u.pn * 256 * KBR * 2 + koff; return true;
    }
    __device__ __forceinline__ void a_ready(const gm::Unit&) const {}
};
constexpr int SPL_LO = 448, SPL_HI = 512, SPL_PM0 = SPL_LO / 16, SPL_PM1 = SPL_HI / 16;
struct SchedOut {
    const char* A; const char* Bt; int G, v; unsigned* ctl;
    __device__ __forceinline__ bool next(int i, gm::Unit& u) const {
        const int nB = NPAN * NCT, extra = nB % G; int L, part = 0;
        if (v < extra) { if (i > 0) return false; L = nB - extra + v; }
        else if (G == 256) { const int r = v - extra; if (i < 2) L = i * (G - extra) + r; else { if (i > 2 || r >= 2 * (SPL_HI - SPL_LO)) return false; L = SPL_LO + (r & 63); part = 2 + (r >> 6); } }
        else { L = i * (G - extra) + (v - extra); if (L >= nB - extra) return false; }
        u.pm = L / NCT; u.pn = L % NCT; u.part = part; u.nt = part ? DM / 128 : DM / 64;
        const size_t koff = (part == 3) ? (size_t)(DM / 2) * 2 : 0;
        u.A = A + (size_t)u.pm * 256 * DM * 2 + koff; u.B = Bt + (size_t)u.pn * 256 * DM * 2 + koff; return true;
    }
    __device__ __forceinline__ void a_ready(const gm::Unit& u) const {
        if (threadIdx.x < 64) (void)panel_wait(ctl + CW_BD + 64 * u.pm, NCT, ctl + CW_TMO);
        asm volatile("" ::: "memory"); __builtin_amdgcn_s_barrier(); asm volatile("" ::: "memory");
    }
};

struct EpiIn {
    unsigned char* ws;
    __device__ __forceinline__ bool operator()(f32x4 (&acc)[2][2][4][2], const gm::Unit& u, int wr, int wc, int fr, int fq) const {
        const int pn = u.pn; bf16_t* base; int ldc, ct, act = 0; float sc = 1.f;
        if (pn < 16)      { base = (bf16_t*)(ws + WS_XL); ldc = DM;  ct = pn; }
        else if (pn < 32) { base = (bf16_t*)(ws + WS_GL); ldc = DM;  ct = pn - 16; act = 1; }
        else if (pn < 40) { base = (bf16_t*)(ws + WS_Q);  ldc = AW;  ct = pn - 32; sc = QSCALE; }
        else if (pn < 42) { base = (bf16_t*)(ws + WS_K);  ldc = KVW; ct = pn - 40; }
        else if (pn < 44) { base = (bf16_t*)(ws + WS_V);  ldc = KVW; ct = pn - 42; }
        else              { base = (bf16_t*)(ws + WS_GA); ldc = AW;  ct = pn - 44; act = 1; }
        const int row0 = u.pm * 256 + wr * 64 + fr, col0 = ct * 256 + wc * 32 + 8 * fq;
        if (pn == 42 || pn == 43) {
#pragma unroll
            for (int ai = 0; ai < 2; ++ai)
#pragma unroll
                for (int m = 0; m < 4; ++m)
#pragma unroll
                    for (int bj = 0; bj < 2; ++bj)
#pragma unroll
                        for (int n = 0; n < 2; ++n)
#pragma unroll
                            for (int e = 0; e < 4; ++e)
                                base[(size_t)(col0 + bj * 128 + 4 * n + e) * MROWS + row0 + ai * 128 + m * 16] = (bf16_t)(cvtpk(acc[ai][bj][m][n][e], 0.f) & 0xffffu);
            return false;
        }
#pragma unroll
        for (int ai = 0; ai < 2; ++ai)
#pragma unroll
            for (int m = 0; m < 4; ++m) { bf16_t* rowp = base + (size_t)(row0 + ai * 128 + m * 16) * ldc + col0;
#pragma unroll
                for (int bj = 0; bj < 2; ++bj) { f32x4 v0 = acc[ai][bj][m][0], v1 = acc[ai][bj][m][1];
                    if (act == 0) { v0 = v0 * sc; v1 = v1 * sc; }
                    else {
#pragma unroll
                        for (int e = 0; e < 4; ++e) { const float s0 = sigmoidf_(v0[e]), s1 = sigmoidf_(v1[e]); v0[e] = (act == 1) ? v0[e] * s0 : s0; v1[e] = (act == 1) ? v1[e] * s1 : s1; }
                    }
                    u32x4 w; w.x = cvtpk(v0[0], v0[1]); w.y = cvtpk(v0[2], v0[3]); w.z = cvtpk(v1[0], v1[1]); w.w = cvtpk(v1[2], v1[3]);
                    *(u32x4*)(rowp + bj * 128) = w; } }
        return false;
    }
};
struct EpiGate {
    unsigned char* ws;
    __device__ __forceinline__ bool operator()(f32x4 (&acc)[2][2][4][2], const gm::Unit& u, int wr, int wc, int fr, int fq) const {
        const int row0 = u.pm * 256 + wr * 64 + fr;
        const float* SX = (const float*)(ws + WS_SX); const float* SW = (const float*)(ws + WS_SW) + u.pn * 256 + wc * 32 + 8 * fq;
        float ka[8], kb[8], sxv[2][4];
#pragma unroll
        for (int ai = 0; ai < 2; ++ai)
#pragma unroll
            for (int m = 0; m < 4; ++m) sxv[ai][m] = SX[row0 + ai * 128 + m * 16];
        { const f32x4 a0 = *(const f32x4*)SW, a1 = *(const f32x4*)(SW + 4), b0 = *(const f32x4*)(SW + 128), b1 = *(const f32x4*)(SW + 132);
#pragma unroll
            for (int e = 0; e < 4; ++e) { ka[e] = -LOG2E * a0[e]; ka[4 + e] = -LOG2E * a1[e]; kb[e] = -LOG2E * b0[e]; kb[4 + e] = -LOG2E * b1[e]; } }
        if (u.pn < NT8_S) {
            const bool ga = u.pn >= NT8_GL; bf16_t* base = (bf16_t*)(ws + (ga ? WS_GA : WS_GL)); const int ldc = ga ? AW : DM, col0 = (ga ? u.pn - NT8_GL : u.pn) * 256 + wc * 32 + 8 * fq;
#pragma unroll
            for (int ai = 0; ai < 2; ++ai)
#pragma unroll
                for (int m = 0; m < 4; ++m) { const int row = row0 + ai * 128 + m * 16; const float sx = sxv[ai][m]; bf16_t* rowp = base + (size_t)row * ldc + col0;
#pragma unroll
                    for (int bj = 0; bj < 2; ++bj) { float o[8];
#pragma unroll
                        for (int n = 0; n < 2; ++n)
#pragma unroll
                            for (int e = 0; e < 4; ++e) { const i32x4 iv = __builtin_bit_cast(i32x4, acc[ai][bj][m][n]); const float t = (float)iv[e] * sx * (bj ? kb[4 * n + e] : ka[4 * n + e]);
                                o[4 * n + e] = t * (-1.0f / LOG2E) * __builtin_amdgcn_rcpf(1.0f + __builtin_amdgcn_exp2f(t)); }
                        u32x4 w; w.x = cvtpk(o[0], o[1]); w.y = cvtpk(o[2], o[3]); w.z = cvtpk(o[4], o[5]); w.w = cvtpk(o[6], o[7]);
                        *(u32x4*)(rowp + bj * 128) = w; } }
            return false;
        }
        if (u.pn < NT8_SQ) {
            bf16_t* base = (bf16_t*)(ws + WS_Q); const int col0 = (u.pn - NT8_S) * 256 + wc * 32 + 8 * fq;
#pragma unroll
            for (int ai = 0; ai < 2; ++ai)
#pragma unroll
                for (int m = 0; m < 4; ++m) { const int row = row0 + ai * 128 + m * 16; const float sx = sxv[ai][m] * (-QSCALE / LOG2E); bf16_t* rowp = base + (size_t)row * AW + col0;
#pragma unroll
                    for (int bj = 0; bj < 2; ++bj) { float o[8];
#pragma unroll
                        for (int n = 0; n < 2; ++n)
#pragma unroll
                            for (int e = 0; e < 4; ++e) { const i32x4 iv = __builtin_bit_cast(i32x4, acc[ai][bj][m][n]); o[4 * n + e] = (float)iv[e] * sx * (bj ? kb[4 * n + e] : ka[4 * n + e]); }
                        u32x4 w; w.x = cvtpk(o[0], o[1]); w.y = cvtpk(o[2], o[3]); w.z = cvtpk(o[4], o[5]); w.w = cvtpk(o[6], o[7]);
                        *(u32x4*)(rowp + bj * 128) = w; } }
            return false;
        }
        const int ct = u.pn - NT8_SQ, cc = ct * 128 + wc * 32 + 8 * fq;
        bf16_t* MAb = (bf16_t*)(ws + WS_MA); bf16_t* MBb = (bf16_t*)(ws + WS_MB);
#pragma unroll
        for (int ai = 0; ai < 2; ++ai)
#pragma unroll
            for (int m = 0; m < 4; ++m) { const int row = row0 + ai * 128 + m * 16; const size_t ro = (size_t)row * DM + cc; const float sx = sxv[ai][m]; float rr[8], sbv[8];
#pragma unroll
                for (int n = 0; n < 2; ++n)
#pragma unroll
                    for (int e = 0; e < 4; ++e) { const i32x4 ia = __builtin_bit_cast(i32x4, acc[ai][0][m][n]), ib = __builtin_bit_cast(i32x4, acc[ai][1][m][n]);
                        const float ea = __builtin_amdgcn_exp2f((float)ia[e] * sx * ka[4 * n + e]), eb = __builtin_amdgcn_exp2f((float)ib[e] * sx * kb[4 * n + e]);
                        rr[4 * n + e] = (1.0f + eb) * __builtin_amdgcn_rcpf(1.0f + ea); sbv[4 * n + e] = __builtin_amdgcn_rcpf(1.0f + eb); }
                u32x4 w; w.x = cvtpk(rr[0], rr[1]); w.y = cvtpk(rr[2], rr[3]); w.z = cvtpk(rr[4], rr[5]); w.w = cvtpk(rr[6], rr[7]);
                *(u32x4*)(MAb + ro) = w;
                w.x = cvtpk(sbv[0], sbv[1]); w.y = cvtpk(sbv[2], sbv[3]); w.z = cvtpk(sbv[4], sbv[5]); w.w = cvtpk(sbv[6], sbv[7]);
                *(u32x4*)(MBb + ro) = w; }
        return false;
    }
};
struct EpiBranch {
    unsigned char* ws; unsigned* ctl;
    __device__ __forceinline__ bool operator()(f32x4 (&acc)[2][2][4][2], const gm::Unit& u, int wr, int wc, int fr, int fq) const {
        const bf16_t* MA = (const bf16_t*)(ws + WS_MA); const bf16_t* MB = (const bf16_t*)(ws + WS_MB);
        const __amdgpu_buffer_rsrc_t rsMG = __builtin_amdgcn_make_buffer_rsrc(ws + WS_XN, 0, (int)((size_t)MROWS * DM * 2), 0x00020000);
        const int row0 = u.pm * 256 + wr * 64 + fr, col0 = u.pn * 256 + wc * 32 + 8 * fq;
        u32x4 mbv[2][4][2];
#pragma unroll
        for (int ai = 0; ai < 2; ++ai)
#pragma unroll
            for (int m = 0; m < 4; ++m)
#pragma unroll
                for (int bj = 0; bj < 2; ++bj) mbv[ai][m][bj] = *(const u32x4*)((u.part ? MB : MA) + (size_t)(row0 + ai * 128 + m * 16) * DM + col0 + bj * 128);
#pragma unroll
        for (int ai = 0; ai < 2; ++ai)
#pragma unroll
            for (int m = 0; m < 4; ++m) { const size_t off = (size_t)(row0 + ai * 128 + m * 16) * DM + col0;
#pragma unroll
                for (int bj = 0; bj < 2; ++bj) {
                    const u32x4 mb = mbv[ai][m][bj];
                    float sb[8] = {bflo(mb.x), bfhi(mb.x), bflo(mb.y), bfhi(mb.y), bflo(mb.z), bfhi(mb.z), bflo(mb.w), bfhi(mb.w)};
                    if (u.part == 0) {
#pragma unroll
                        for (int e = 0; e < 4; ++e) { acc[ai][bj][m][0][e] *= sb[e]; acc[ai][bj][m][1][e] *= sb[4 + e]; }
                    } else {
                        const f32x4 v0 = acc[ai][bj][m][0], v1 = acc[ai][bj][m][1];
                        u32x4 w; w.x = cvtpk(v0[0] * sb[0], v0[1] * sb[1]); w.y = cvtpk(v0[2] * sb[2], v0[3] * sb[3]); w.z = cvtpk(v1[0] * sb[4], v1[1] * sb[5]); w.w = cvtpk(v1[2] * sb[6], v1[3] * sb[7]);
                        store16_wt(rsMG, (off + bj * 128) * 2, w);
                    } } }
        if (u.part) panel_signal(ctl + CW_BD + 64 * u.pm);
        return u.part == 0;
    }
};
struct EpiOut {
    unsigned char* ws; unsigned* ctl;
    __device__ __forceinline__ bool operator()(f32x4 (&acc)[2][2][4][2], const gm::Unit& u, int wr, int wc, int fr, int fq) const {
        const bool second = (u.part == 3);
        const __amdgpu_buffer_rsrc_t rsOF = second ? __builtin_amdgcn_make_buffer_rsrc(ws + WS_OF1, 0, (int)((size_t)(SPL_PM1 - SPL_PM0) * 256 * DM * 2), 0x00020000)
                                                   : __builtin_amdgcn_make_buffer_rsrc(ws + WS_HLOC, 0, (int)((size_t)MROWS * DM * 2), 0x00020000);
        const int row0 = (second ? u.pm - SPL_PM0 : u.pm) * 256 + wr * 64 + fr, col0 = u.pn * 256 + wc * 32 + 8 * fq;
#pragma unroll
        for (int ai = 0; ai < 2; ++ai)
#pragma unroll
            for (int m = 0; m < 4; ++m) { const size_t ro = (size_t)(row0 + ai * 128 + m * 16) * DM + col0;
#pragma unroll
                for (int bj = 0; bj < 2; ++bj) { const f32x4 v0 = acc[ai][bj][m][0], v1 = acc[ai][bj][m][1];
                    u32x4 w; w.x = cvtpk(v0[0], v0[1]); w.y = cvtpk(v0[2], v0[3]); w.z = cvtpk(v1[0], v1[1]); w.w = cvtpk(v1[2], v1[3]);
                    store16_wt(rsOF, (ro + bj * 128) * 2, w); } }
        panel_signal(ctl + CW_OD + 64 * u.pm);
        return false;
    }
};

__device__ __forceinline__ int xc_byte(int row, int k) { return row * 512 + ((k * 2) ^ ((row & 15) << 4)); }
template <int D> __device__ __forceinline__ float dpp_shr(float v, float fill) {
    return __int_as_float(__builtin_amdgcn_update_dpp(__float_as_int(fill), __float_as_int(v), 0x110 + D, 0xF, 0xF, false));
}
template <int D> __device__ __forceinline__ void scan_step(float& A, float& H, bool on) {
    const float pa = dpp_shr<D>(A, 1.0f), ph = dpp_shr<D>(H, 0.0f);
    if (on) { H = A * ph + H; A = pa * A; }
}
template <int D> __device__ __forceinline__ void scan4(float& H0, float& H1, float& H2, float& H3, float& A0, float& A1, float& A2, float& A3) {
    if (D == 1) asm volatile("s_nop 1");
    asm volatile(
        "v_fmac_f32_dpp %0, %0, %4 row_shr:%c8 row_mask:0xf bank_mask:0xf\n\t"
        "v_fmac_f32_dpp %1, %1, %5 row_shr:%c8 row_mask:0xf bank_mask:0xf\n\t"
        "v_fmac_f32_dpp %2, %2, %6 row_shr:%c8 row_mask:0xf bank_mask:0xf\n\t"
        "v_fmac_f32_dpp %3, %3, %7 row_shr:%c8 row_mask:0xf bank_mask:0xf\n\t"
        "v_mul_f32_dpp %4, %4, %4 row_shr:%c8 row_mask:0xf bank_mask:0xf\n\t"
        "v_mul_f32_dpp %5, %5, %5 row_shr:%c8 row_mask:0xf bank_mask:0xf\n\t"
        "v_mul_f32_dpp %6, %6, %6 row_shr:%c8 row_mask:0xf bank_mask:0xf\n\t"
        "v_mul_f32_dpp %7, %7, %7 row_shr:%c8 row_mask:0xf bank_mask:0xf"
        : "+v"(H0), "+v"(H1), "+v"(H2), "+v"(H3), "+v"(A0), "+v"(A1), "+v"(A2), "+v"(A3) : "i"(D));
}
template <bool SAMP>
__device__ __forceinline__ void lru_item(const Frame& F, const Args& a, int c, int j) {
    unsigned char* ws = a.ws;
    const bf16_t* XL = (const bf16_t*)(ws + WS_XL);
    int tid = F.tid; asm volatile("" : "+v"(tid));
    const int lane = tid & 63, w = F.wave;
    LAS unsigned char* At = F.lds;
    const int row0 = c * 128;
    {
        const int cg = tid & 31, rg = tid >> 5, chb = j * BLK + cg * 8, r0 = row0 + rg * 8;
        float cw[4][8], cb[8];
#pragma unroll
        for (int t = 0; t < 4; ++t) { const f32x4 w0 = *(const f32x4*)(a.in[I_CONVW] + (size_t)t * DM + chb), w1 = *(const f32x4*)(a.in[I_CONVW] + (size_t)t * DM + chb + 4);
#pragma unroll
            for (int e = 0; e < 4; ++e) { cw[t][e] = w0[e]; cw[t][4 + e] = w1[e]; } }
        { const f32x4 b0 = *(const f32x4*)(a.in[I_CONVB] + chb), b1 = *(const f32x4*)(a.in[I_CONVB] + chb + 4);
#pragma unroll
            for (int e = 0; e < 4; ++e) { cb[e] = b0[e]; cb[4 + e] = b1[e]; } }
        u32x4 xr[8];
#pragma unroll
        for (int i = 0; i < 8; ++i) xr[i] = *(const u32x4*)(XL + (size_t)(r0 + i) * DM + chb);
        float h3[8], h2[8], h1[8];
#define UNPK(dst, v) do { dst[0] = bflo(v.x); dst[1] = bfhi(v.x); dst[2] = bflo(v.y); dst[3] = bfhi(v.y); dst[4] = bflo(v.z); dst[5] = bfhi(v.z); dst[6] = bflo(v.w); dst[7] = bfhi(v.w); } while (0)
        if (!SAMP) {
            if (r0 >= 3) { const u32x4 p3 = *(const u32x4*)(XL + (size_t)(r0 - 3) * DM + chb), p2 = *(const u32x4*)(XL + (size_t)(r0 - 2) * DM + chb), p1 = *(const u32x4*)(XL + (size_t)(r0 - 1) * DM + chb);
                UNPK(h3, p3); UNPK(h2, p2); UNPK(h1, p1); }
            else {
#pragma unroll
                for (int e = 0; e < 8; ++e) { h3[e] = 0.f; h2[e] = 0.f; h1[e] = 0.f; } }
        }
#pragma unroll
        for (int i = 0; i < 8; ++i) {
            if (SAMP && (i & 3) == 0) {
                const int b = (r0 + i - SEQ) >> 2; const float* sc = a.in[I_SCONV] + (size_t)b * 3 * DM + chb;
                const f32x4 a0 = *(const f32x4*)(sc), a1 = *(const f32x4*)(sc + 4), b0 = *(const f32x4*)(sc + DM), b1 = *(const f32x4*)(sc + DM + 4), c0 = *(const f32x4*)(sc + 2 * DM), c1 = *(const f32x4*)(sc + 2 * DM + 4);
#pragma unroll
                for (int e = 0; e < 4; ++e) { h3[e] = a0[e]; h3[4 + e] = a1[e]; h2[e] = b0[e]; h2[4 + e] = b1[e]; h1[e] = c0[e]; h1[4 + e] = c1[e]; }
            }
            float x[8]; UNPK(x, xr[i]);
            float o[8];
#pragma unroll
            for (int e = 0; e < 8; ++e) { o[e] = cb[e] + cw[0][e] * h3[e] + cw[1][e] * h2[e] + cw[2][e] * h1[e] + cw[3][e] * x[e]; h3[e] = h2[e]; h2[e] = h1[e]; h1[e] = x[e]; }
            u32x4 pk; pk.x = cvtpk(o[0], o[1]); pk.y = cvtpk(o[2], o[3]); pk.z = cvtpk(o[4], o[5]); pk.w = cvtpk(o[6], o[7]);
            *(LAS u32x4*)(At + xc_byte(rg * 8 + i, cg * 8)) = pk;
        }
#undef UNPK
    }
    __syncthreads();
    const int fr = lane & 15, fq = lane >> 4;
    bf16_t* OAB = (bf16_t*)(ws + WS_OAB); const bf16_t* GL = (const bf16_t*)(ws + WS_GL);
    const __amdgpu_buffer_rsrc_t rsA = __builtin_amdgcn_make_buffer_rsrc(ws + WS_CARA, 0, (SEQ / 128) * DM * 4, 0x00020000), rsH = __builtin_amdgcn_make_buffer_rsrc(ws + WS_CARH, 0, (SEQ / 128) * DM * 4, 0x00020000),
                                 rsP = __builtin_amdgcn_make_buffer_rsrc(ws + WS_PSS, 0, (SEQ / 128) * DM * 4, 0x00020000);
#pragma unroll 1
    for (int nt = 0; nt < 2; ++nt) {
        const int nb = 32 * w + 16 * nt, chl = nb + 4 * fq, ch = j * BLK + chl;
        const float* lc = (const float*)(ws + WS_LC) + ch;
        const f32x4 nba = *(const f32x4*)lc, nbx = *(const f32x4*)(lc + DM), nc8l = *(const f32x4*)(lc + 2 * DM);
        f32x4 acc[8][2];
#pragma unroll
        for (int m = 0; m < 8; ++m)
#pragma unroll
            for (int g = 0; g < 2; ++g) acc[m][g] = (f32x4){0.f, 0.f, 0.f, 0.f};
        {
            const bf16_t* WGb = (const bf16_t*)(ws + WS_WG) + (size_t)(j * 2) * BLK * BLK + (size_t)(nb + fr) * BLK + 8 * fq;
            bf16x8 wf[4][2];
#pragma unroll
            for (int ks = 0; ks < 4; ++ks)
#pragma unroll
                for (int g = 0; g < 2; ++g) wf[ks][g] = *(const bf16x8*)(WGb + (size_t)g * BLK * BLK + 32 * ks);
            __builtin_amdgcn_sched_barrier(0);
#pragma unroll
            for (int ks = 0; ks < 8; ++ks) {
                bf16x8 xf[8];
#pragma unroll
                for (int m = 0; m < 8; ++m) xf[m] = *(const LAS bf16x8*)(At + xc_byte(16 * m + fr, 32 * ks + 8 * fq));
                __builtin_amdgcn_sched_barrier(0);
                __builtin_amdgcn_s_setprio(1);
#pragma unroll
                for (int m = 0; m < 8; ++m) { acc[m][0] = __builtin_amdgcn_mfma_f32_16x16x32_bf16(wf[ks & 3][0], xf[m], acc[m][0], 0, 0, 0); acc[m][1] = __builtin_amdgcn_mfma_f32_16x16x32_bf16(wf[ks & 3][1], xf[m], acc[m][1], 0, 0, 0); }
                __builtin_amdgcn_s_setprio(0);
                __builtin_amdgcn_sched_barrier(0);
                if (ks < 4) {
#pragma unroll
                    for (int g = 0; g < 2; ++g) wf[ks][g] = *(const bf16x8*)(WGb + (size_t)g * BLK * BLK + 32 * (ks + 4));
                }
            }
        }
        float Av[8][4], Hv[8][4];
#pragma unroll
        for (int m = 0; m < 8; ++m) {
            const u32x2 xw = *(const LAS u32x2*)(At + xc_byte(16 * m + fr, chl));
            const float xcv[4] = {bflo(xw.x), bfhi(xw.x), bflo(xw.y), bfhi(xw.y)};
#pragma unroll
            for (int r = 0; r < 4; ++r) {
                const float ga = __builtin_amdgcn_rcpf(1.0f + __builtin_amdgcn_exp2f(__builtin_fmaf(acc[m][0][r], -LOG2E, nba[r])));
                const float gx = __builtin_amdgcn_rcpf(1.0f + __builtin_amdgcn_exp2f(__builtin_fmaf(acc[m][1][r], -LOG2E, nbx[r])));
                const float av = __builtin_amdgcn_exp2f(nc8l[r] * ga);
                const float m2 = __builtin_fmaf(-av, av, 1.0f);
                Av[m][r] = av; Hv[m][r] = __builtin_amdgcn_sqrtf(m2) * (gx * xcv[r]);
            }
            if (SAMP) {
#pragma unroll
                for (int r = 0; r < 4; ++r) { scan_step<1>(Av[m][r], Hv[m][r], (fr & 3) >= 1); scan_step<2>(Av[m][r], Hv[m][r], (fr & 3) >= 2); }
            } else {
                scan4<1>(Hv[m][0], Hv[m][1], Hv[m][2], Hv[m][3], Av[m][0], Av[m][1], Av[m][2], Av[m][3]);
                scan4<2>(Hv[m][0], Hv[m][1], Hv[m][2], Hv[m][3], Av[m][0], Av[m][1], Av[m][2], Av[m][3]);
                scan4<4>(Hv[m][0], Hv[m][1], Hv[m][2], Hv[m][3], Av[m][0], Av[m][1], Av[m][2], Av[m][3]);
                scan4<8>(Hv[m][0], Hv[m][1], Hv[m][2], Hv[m][3], Av[m][0], Av[m][1], Av[m][2], Av[m][3]);
            }
            __builtin_amdgcn_sched_barrier(0);
        }
        if (SAMP) {
#pragma unroll
            for (int m = 0; m < 8; ++m) {
                const int row = row0 + 16 * m + fr, b = (row - SEQ) >> 2;
                const f32x4 h0 = *(const f32x4*)(a.in[I_SH] + (size_t)b * DM + ch);
                const u32x2 gw = *(const u32x2*)(GL + (size_t)row * DM + ch);
                f32x4 h;
#pragma unroll
                for (int r = 0; r < 4; ++r) h[r] = Av[m][r] * h0[r] + Hv[m][r];
                u32x2 o; o.x = cvtpk(h[0] * bflo(gw.x), h[1] * bfhi(gw.x)); o.y = cvtpk(h[2] * bflo(gw.y), h[3] * bfhi(gw.y));
                *(u32x2*)(OAB + (size_t)row * KBR + ch) = o;
                if ((fr & 3) == 3) *(f32x4*)(a.out + O_HS + (size_t)b * DM + ch) = h;
            }
        } else {
            const int bsel = (lane | 15) << 2;
            f32x4 CA, CH;
#pragma unroll
            for (int r = 0; r < 4; ++r) { float ca = Av[0][r], hh = Hv[0][r];
#pragma unroll
                for (int m = 1; m < 8; ++m) { hh = __builtin_fmaf(Av[m][r], hh, Hv[m][r]); ca *= Av[m][r]; }
                CA[r] = __int_as_float(__builtin_amdgcn_ds_bpermute(bsel, __float_as_int(ca))); CH[r] = __int_as_float(__builtin_amdgcn_ds_bpermute(bsel, __float_as_int(hh))); }
            const int gofs = (c * DM + ch) * 4;
            if (c > 0 && fr == 0) { __builtin_amdgcn_raw_buffer_store_b128(__builtin_bit_cast(u32x4, CA), rsA, gofs, 0, 17); __builtin_amdgcn_raw_buffer_store_b128(__builtin_bit_cast(u32x4, CH), rsH, gofs, 0, 17); }
            u32x2 gw[8];
#pragma unroll
            for (int m = 0; m < 8; ++m) gw[m] = *(const u32x2*)(GL + (size_t)(row0 + 16 * m + fr) * DM + ch);
            f32x4 hin = (f32x4){0.f, 0.f, 0.f, 0.f};
            if (c > 0) {
                const int pc = c - 16 + fr, pofs = ((pc < 0 ? 0 : pc) * DM + ch) * 4;
                float EA[4], EH[4]; unsigned sp = 0;
                for (;;) {
                    asm volatile("" ::: "memory");
                    const u32x4 pv = __builtin_amdgcn_raw_buffer_load_b128(rsP, pofs, 0, 17), av = __builtin_amdgcn_raw_buffer_load_b128(rsA, pofs, 0, 17), hv = __builtin_amdgcn_raw_buffer_load_b128(rsH, pofs, 0, 17);
                    const bool okP = pc < 0 || (pv.x != LB_SENT && pv.y != LB_SENT && pv.z != LB_SENT && pv.w != LB_SENT);
                    const bool okA = !okP && av.x != LB_SENT && av.y != LB_SENT && av.z != LB_SENT && av.w != LB_SENT && hv.x != LB_SENT && hv.y != LB_SENT && hv.z != LB_SENT && hv.w != LB_SENT;
#pragma unroll
                    for (int r = 0; r < 4; ++r) { EA[r] = okA ? __uint_as_float(av[r]) : 0.f; EH[r] = okP ? (pc < 0 ? 0.f : __uint_as_float(pv[r])) : okA ? __uint_as_float(hv[r]) : 0.f; }
                    const unsigned long long bp = __ballot(okP), ba = __ballot(okA);
                    const unsigned pf = (unsigned)(bp >> (16 * fq)) & 0xffffu, ag = (unsigned)(ba >> (16 * fq)) & 0xffffu;
                    bool ok = pf != 0u;
                    if (ok) { const int hi = 31 - __builtin_clz(pf); ok = ((~ag) & 0xffffu & ~((2u << hi) - 1u)) == 0u; }
                    if (__all(ok)) break;
                    __builtin_amdgcn_s_sleep(8);
                    if ((++sp & 63u) == 0u) { unsigned* tmo = (unsigned*)(ws + WS_CTL) + CW_TMO;
                        if (__hip_atomic_load(tmo, __ATOMIC_RELAXED, __HIP_MEMORY_SCOPE_AGENT)) break;
                        if (sp > (1u << 16)) { __hip_atomic_store(tmo, 1u, __ATOMIC_RELAXED, __HIP_MEMORY_SCOPE_AGENT); break; } }
                }
                scan4<1>(EH[0], EH[1], EH[2], EH[3], EA[0], EA[1], EA[2], EA[3]); scan4<2>(EH[0], EH[1], EH[2], EH[3], EA[0], EA[1], EA[2], EA[3]);
                scan4<4>(EH[0], EH[1], EH[2], EH[3], EA[0], EA[1], EA[2], EA[3]); scan4<8>(EH[0], EH[1], EH[2], EH[3], EA[0], EA[1], EA[2], EA[3]);
#pragma unroll
                for (int r = 0; r < 4; ++r) hin[r] = __int_as_float(__builtin_amdgcn_ds_bpermute(bsel, __float_as_int(EH[r])));
            }
            {
                f32x4 pe;
#pragma unroll
                for (int r = 0; r < 4; ++r) pe[r] = __builtin_fmaf(CA[r], hin[r], CH[r]);
                if (fr == 0) { __builtin_amdgcn_raw_buffer_store_b128(__builtin_bit_cast(u32x4, pe), rsP, gofs, 0, 17); if (c == SEQ / 128 - 1) *(f32x4*)(a.out + O_HP + ch) = pe; }
            }
            f32x4 C = hin;
#pragma unroll
            for (int m = 0; m < 8; ++m) {
                f32x4 TA, TH, h;
#pragma unroll
                for (int r = 0; r < 4; ++r) { TA[r] = __int_as_float(__builtin_amdgcn_ds_bpermute(bsel, __float_as_int(Av[m][r]))); TH[r] = __int_as_float(__builtin_amdgcn_ds_bpermute(bsel, __float_as_int(Hv[m][r])));
                    h[r] = __builtin_fmaf(Av[m][r], C[r], Hv[m][r]); }
                u32x2 o; o.x = cvtpk(h[0] * bflo(gw[m].x), h[1] * bfhi(gw[m].x)); o.y = cvtpk(h[2] * bflo(gw[m].y), h[3] * bfhi(gw[m].y));
                *(LAS u32x2*)(At + LRU_OT + xc_byte(16 * m + fr, chl)) = o;
#pragma unroll
                for (int r = 0; r < 4; ++r) C[r] = __builtin_fmaf(TA[r], C[r], TH[r]);
            }
        }
    }
    if (!SAMP) {
        __syncthreads();
#pragma unroll
        for (int ps = 0; ps < 8; ++ps) { const int row = ps * 16 + (tid >> 5), q = tid & 31;
            const u32x4 v = *(const LAS u32x4*)(At + LRU_OT + xc_byte(row, q * 8));
            *(u32x4*)(OAB + (size_t)(row0 + row) * KBR + j * BLK + q * 8) = v; }
    }
    __syncthreads();
}

__device__ __forceinline__ int crow(int r, int hi) { return (r & 3) + 8 * (r >> 2) + 4 * hi; }
constexpr int AT_KSTR = 144, AT_VSTR = 520, AT_K = 0, AT_V = 256 * AT_KSTR, AT_O = AT_V + 64 * AT_VSTR;
static_assert(AT_O % 16 == 0 && AT_O + 8 * 4096 <= RING_BYTES, "attention LDS map");

__device__ __forceinline__ void attn_item(const Frame& F, const Args& a, int b, int g) {
    unsigned char* ws = a.ws;
    const bf16_t* Qb = (const bf16_t*)(ws + WS_Q); const bf16_t* Kb = (const bf16_t*)(ws + WS_K); const bf16_t* VT = (const bf16_t*)(ws + WS_V);
    const bf16_t* GA = (const bf16_t*)(ws + WS_GA); bf16_t* OAB = (bf16_t*)(ws + WS_OAB);
    int tid = F.tid; asm volatile("" : "+v"(tid));
    const int lane = tid & 63, w = F.wave, r = lane & 31, h = lane >> 5;
    LAS unsigned char* Kt = F.lds + AT_K; LAS unsigned char* Vt = F.lds + AT_V; LAS unsigned char* Ost = F.lds + AT_O + w * 4096;
    bf16x8 qfa[2][4]; u32x4 gaa[2][4];
#pragma unroll
    for (int si = 0; si < 2; ++si) { const int s_ = 2 * (w >> 2) + si, head_ = 4 * g + (w & 3);
#pragma unroll
        for (int ds = 0; ds < 4; ++ds) qfa[si][ds] = *(const bf16x8*)(Qb + (size_t)(128 * b + 32 * s_ + r) * AW + head_ * HD + 16 * ds + 8 * h);
#pragma unroll
        for (int i = 0; i < 4; ++i) gaa[si][i] = *(const u32x4*)(GA + (size_t)(128 * b + 32 * s_ + i * 8 + (lane >> 3)) * AW + head_ * HD + (lane & 7) * 8); }
    u32x4 kv[4], vv[4];
#pragma unroll
    for (int i = 0; i < 4; ++i) { const int p = tid + 512 * i, key = p >> 3, ck = p & 7; const int kr = 128 * (b - 1) + key;
        kv[i] = *(const u32x4*)(Kb + (size_t)(kr < 0 ? 0 : kr) * KVW + g * HD + ck * 8); }
#pragma unroll
    for (int i = 0; i < 4; ++i) { const int p = tid + 512 * i, d = p >> 5, ck = p & 31; const int tk = 128 * (b - 1) + ck * 8;
        vv[i] = *(const u32x4*)(VT + (size_t)(g * HD + d) * MROWS + (tk < 0 ? 0 : tk)); }
#pragma unroll
    for (int i = 0; i < 4; ++i) { const int p = tid + 512 * i, key = p >> 3, ck = p & 7;
        const u32x4 v = (b > 0 || key >= 128) ? kv[i] : (u32x4){0u, 0u, 0u, 0u};
        *(LAS u32x4*)(Kt + key * AT_KSTR + ck * 16) = v; }
#pragma unroll
    for (int i = 0; i < 4; ++i) { const int p = tid + 512 * i, d = p >> 5, ck = p & 31;
        const u32x4 v = (b > 0 || ck >= 16) ? vv[i] : (u32x4){0u, 0u, 0u, 0u};
        *(LAS u32x2*)(Vt + d * AT_VSTR + ck * 16) = (u32x2){v.x, v.y}; *(LAS u32x2*)(Vt + d * AT_VSTR + ck * 16 + 8) = (u32x2){v.z, v.w}; }
    __syncthreads();
    const int hq = w & 3, head = 4 * g + hq;
    const float sink2 = a.in[I_SINK][head] * LOG2E;
#pragma unroll
    for (int si = 0; si < 2; ++si) {
        const int s = 2 * (w >> 2) + si;
        const bf16x8 (&qf)[4] = qfa[si];
        f32x16 st[5];
        __builtin_amdgcn_s_setprio(1);
#pragma unroll
        for (int tt = 0; tt < 5; ++tt) {
            st[tt] = (f32x16){};
            const LAS unsigned char* kp = Kt + (32 * (s + tt) + r) * AT_KSTR + 16 * h;
#pragma unroll
            for (int ds = 0; ds < 4; ++ds) st[tt] = __builtin_amdgcn_mfma_f32_32x32x16_bf16(*(const LAS bf16x8*)(kp + 32 * ds), qf[ds], st[tt], 0, 0, 0);
        }
        __builtin_amdgcn_s_setprio(0);
        float mx = -1e30f;
#pragma unroll
        for (int tt = 0; tt < 5; ++tt) {
            const bool dead = (b == 0) && (s + tt < 4);
#pragma unroll
            for (int e = 0; e < 16; ++e) { const int cr = crow(e, h); const bool ok = !dead && (tt != 0 || cr >= r) && (tt != 4 || cr <= r);
                st[tt][e] = ok ? st[tt][e] : -1e30f; mx = fmaxf(mx, st[tt][e]); }
        }
        mx = fmaxf(mx, __shfl_xor(mx, 32)); mx = fmaxf(mx, sink2);
        float sum = 0.f;
#pragma unroll
        for (int tt = 0; tt < 5; ++tt)
#pragma unroll
            for (int e = 0; e < 16; ++e) { const float p = __builtin_amdgcn_exp2f(st[tt][e] - mx); st[tt][e] = p; sum += p; }
        sum += __shfl_xor(sum, 32); sum += __builtin_amdgcn_exp2f(sink2 - mx);
        const float inv = __builtin_amdgcn_rcpf(sum);
        f32x16 o[2]; o[0] = (f32x16){}; o[1] = (f32x16){};
        __builtin_amdgcn_s_setprio(1);
#pragma unroll
        for (int tt = 0; tt < 5; ++tt)
#pragma unroll
            for (int ks = 0; ks < 2; ++ks) {
                u32x4 pw; pw.x = cvtpk(st[tt][8 * ks + 0] * inv, st[tt][8 * ks + 1] * inv); pw.y = cvtpk(st[tt][8 * ks + 2] * inv, st[tt][8 * ks + 3] * inv);
                pw.z = cvtpk(st[tt][8 * ks + 4] * inv, st[tt][8 * ks + 5] * inv); pw.w = cvtpk(st[tt][8 * ks + 6] * inv, st[tt][8 * ks + 7] * inv);
                const bf16x8 pa = __builtin_bit_cast(bf16x8, pw);
#pragma unroll
                for (int dh = 0; dh < 2; ++dh) { const LAS unsigned char* vp = Vt + (32 * dh + r) * AT_VSTR + (32 * (s + tt) + 16 * ks + 4 * h) * 2;
                    const u32x2 lo = *(const LAS u32x2*)vp, hi2 = *(const LAS u32x2*)(vp + 16);
                    const u32x4 vw = (u32x4){lo.x, lo.y, hi2.x, hi2.y};
                    o[dh] = __builtin_amdgcn_mfma_f32_32x32x16_bf16(pa, __builtin_bit_cast(bf16x8, vw), o[dh], 0, 0, 0); }
            }
        __builtin_amdgcn_s_setprio(0);
#pragma unroll
        for (int e = 0; e < 16; ++e)
#pragma unroll
            for (int dh = 0; dh < 2; ++dh) *(LAS unsigned short*)(Ost + crow(e, h) * 128 + (32 * dh + r) * 2) = (unsigned short)(cvtpk(o[dh][e], 0.f) & 0xffffu);
        LDS_WAIT();
#pragma unroll
        for (int i = 0; i < 4; ++i) { const int row = i * 8 + (lane >> 3), ck = lane & 7; const size_t grow = (size_t)(128 * b + 32 * s + row);
            const u32x4 ov = *(const LAS u32x4*)(Ost + row * 128 + ck * 16);
            const u32x4 gv = gaa[si][i];
            u32x4 res; res.x = cvtpk(bflo(ov.x) * bflo(gv.x), bfhi(ov.x) * bfhi(gv.x)); res.y = cvtpk(bflo(ov.y) * bflo(gv.y), bfhi(ov.y) * bfhi(gv.y));
            res.z = cvtpk(bflo(ov.z) * bflo(gv.z), bfhi(ov.z) * bfhi(gv.z)); res.w = cvtpk(bflo(ov.w) * bflo(gv.w), bfhi(ov.w) * bfhi(gv.w));
            *(u32x4*)(OAB + grow * KBR + DM + head * HD + ck * 8) = res; }
        LDS_WAIT();
    }
    __syncthreads();
}

__device__ __forceinline__ void attn_sample_unit(const Frame& F, const Args& a, int u) {
    unsigned char* ws = a.ws;
    const bf16_t* Qb = (const bf16_t*)(ws + WS_Q); const bf16_t* Kb = (const bf16_t*)(ws + WS_K); const bf16_t* VT = (const bf16_t*)(ws + WS_V);
    const bf16_t* KC = (const bf16_t*)(ws + WS_KC); const bf16_t* VCT = (const bf16_t*)(ws + WS_VCT);
    const bf16_t* GA = (const bf16_t*)(ws + WS_GA); bf16_t* OAB = (bf16_t*)(ws + WS_OAB);
    int lane = F.lane; asm volatile("" : "+v"(lane)); asm volatile("" : "+s"(u));
    const int r = lane & 31, h = lane >> 5, sb = u >> 3, g = u & 7;
    const int qrow = SEQ + 4 * sb + (r & 3), head = 4 * g + ((r >> 2) & 3), qi = r & 3;
    bf16x8 qf[4];
#pragma unroll
    for (int ds = 0; ds < 4; ++ds) qf[ds] = *(const bf16x8*)(Qb + (size_t)qrow * AW + head * HD + 16 * ds + 8 * h);
    const float sink2 = a.in[I_SINK][head] * LOG2E;
    f32x16 st[5];
#pragma unroll
    for (int T = 0; T < 5; ++T) {
        st[T] = (f32x16){};
        const bf16_t* kp;
        if (T < 4) kp = KC + ((size_t)sb * WIN + 32 * T + r) * KVW + g * HD + 8 * h;
        else { int krow = SEQ + 4 * sb + r; krow = krow < MROWS ? krow : MROWS - 1; kp = Kb + (size_t)krow * KVW + g * HD + 8 * h; }
#pragma unroll
        for (int ds = 0; ds < 4; ++ds) st[T] = __builtin_amdgcn_mfma_f32_32x32x16_bf16(*(const bf16x8*)(kp + 16 * ds), qf[ds], st[T], 0, 0, 0);
    }
    float mx = -1e30f;
#pragma unroll
    for (int T = 0; T < 5; ++T)
#pragma unroll
        for (int e = 0; e < 16; ++e) { const int kk = 32 * T + crow(e, h); const bool ok = (kk >= qi) && (kk <= qi + WIN);
            st[T][e] = ok ? st[T][e] : -1e30f; mx = fmaxf(mx, st[T][e]); }
    mx = fmaxf(mx, __shfl_xor(mx, 32)); mx = fmaxf(mx, sink2);
    float sum = 0.f;
#pragma unroll
    for (int T = 0; T < 5; ++T)
#pragma unroll
        for (int e = 0; e < 16; ++e) { const float p = __builtin_amdgcn_exp2f(st[T][e] - mx); st[T][e] = p; sum += p; }
    sum += __shfl_xor(sum, 32); sum += __builtin_amdgcn_exp2f(sink2 - mx);
    const float inv = __builtin_amdgcn_rcpf(sum);
    f32x16 o[2]; o[0] = (f32x16){}; o[1] = (f32x16){};
#pragma unroll
    for (int T = 0; T < 5; ++T)
#pragma unroll
        for (int ks = 0; ks < 2; ++ks) {
            if (T == 4 && ks == 1) continue;
            u32x4 pw; pw.x = cvtpk(st[T][8 * ks + 0] * inv, st[T][8 * ks + 1] * inv); pw.y = cvtpk(st[T][8 * ks + 2] * inv, st[T][8 * ks + 3] * inv);
            pw.z = cvtpk(st[T][8 * ks + 4] * inv, st[T][8 * ks + 5] * inv); pw.w = cvtpk(st[T][8 * ks + 6] * inv, st[T][8 * ks + 7] * inv);
            const bf16x8 pa = __builtin_bit_cast(bf16x8, pw);
#pragma unroll
            for (int dh = 0; dh < 2; ++dh) {
                u32x2 lo, hi2;
                if (T < 4) { const bf16_t* vp = VCT + ((size_t)sb * KVW + g * HD + 32 * dh + r) * WIN + 32 * T + 16 * ks + 4 * h; lo = *(const u32x2*)vp; hi2 = *(const u32x2*)(vp + 8); }
                else { const bf16_t* vp = VT + (size_t)(g * HD + 32 * dh + r) * MROWS + SEQ + 4 * sb; lo = *(const u32x2*)vp; if (h) { lo.x = 0u; lo.y = 0u; } hi2.x = 0u; hi2.y = 0u; }
                const u32x4 vw = (u32x4){lo.x, lo.y, hi2.x, hi2.y};
                o[dh] = __builtin_amdgcn_mfma_f32_32x32x16_bf16(pa, __builtin_bit_cast(bf16x8, vw), o[dh], 0, 0, 0);
            }
        }
#pragma unroll
    for (int e = 0; e < 16; ++e) {
        const int qq = crow(e, h); if (qq >= 16) continue;
        const int orow = SEQ + 4 * sb + (qq & 3), ohead = 4 * g + ((qq >> 2) & 3);
#pragma unroll
        for (int dh = 0; dh < 2; ++dh) { const int cidx = ohead * HD + 32 * dh + r;
            OAB[(size_t)orow * KBR + DM + cidx] = (bf16_t)(cvtpk(o[dh][e] * bf2f(GA[(size_t)orow * AW + cidx]), 0.f) & 0xffffu); }
    }
}

__device__ __forceinline__ void p2_mixers(const Frame& F, const Args& a) {
    unsigned char* ws = a.ws;
#ifndef DUP_SUB
#define DUP_SUB 0
#endif
    {
        constexpr int nL = (MROWS / 128) * NBLK, nA = (SEQ / 128) * NKV, nS = DECB * NKV / NWAVES, nT = nL + nA + nS;
        volatile LAS unsigned* bc = (volatile LAS unsigned*)(F.lds + MISC_OFF + 64);
        unsigned* q = (unsigned*)(ws + WS_CTL) + CW_Q2;
        if (F.tid == 0) bc[0] = __hip_atomic_fetch_add(q, 1u, __ATOMIC_RELAXED, __HIP_MEMORY_SCOPE_AGENT);
        __syncthreads();
        int cur = (int)bc[0];
        __syncthreads();
        while (cur < nT) {
            unsigned nxt = 0u;
            if (F.tid == 0) nxt = __hip_atomic_fetch_add(q, 1u, __ATOMIC_RELAXED, __HIP_MEMORY_SCOPE_AGENT);
            if (cur < nL) { const int c = cur / NBLK, j = cur % NBLK; if (c < SEQ / 128) lru_item<false>(F, a, c, j); else lru_item<true>(F, a, c, j); }
            else if (cur < nL + nA) { const int it = cur - nL; attn_item(F, a, it / NKV, it % NKV); }
            else attn_sample_unit(F, a, (cur - nL - nA) * NWAVES + F.wave);
            if (F.tid == 0) bc[0] = nxt;
            __syncthreads();
            cur = (int)bc[0];
            __syncthreads();
        }
    }
    for (int rp = 0; rp < (DUP_SUB == 4 ? 2 : 1); ++rp) {
    const bf16_t* XL = (const bf16_t*)(ws + WS_XL); const bf16_t* Kb = (const bf16_t*)(ws + WS_K); const bf16_t* VT = (const bf16_t*)(ws + WS_V);
    const size_t gt = (size_t)F.vcu * 512 + F.tid, NT = (size_t)F.G * 512;
    for (size_t i = gt; i < (size_t)WIN * KVW; i += NT) { a.out[O_KP + i] = bf2f(Kb[(size_t)(SEQ - WIN) * KVW + i]); a.out[O_VP + i] = bf2f(VT[(i % KVW) * MROWS + (SEQ - WIN) + i / KVW]); }
    for (size_t i = gt; i < (size_t)DECB * DECT * KVW; i += NT) { const size_t b = i / (DECT * KVW), rem = i % (DECT * KVW);
        a.out[O_KS + b * WIN * KVW + (size_t)(WIN - DECT) * KVW + rem] = bf2f(Kb[(size_t)SEQ * KVW + i]); a.out[O_VS + b * WIN * KVW + (size_t)(WIN - DECT) * KVW + rem] = bf2f(VT[(i % KVW) * MROWS + SEQ + i / KVW]); }
    for (size_t i = gt; i < (size_t)3 * DM; i += NT) a.out[O_CP + i] = bf2f(XL[(size_t)(SEQ - 3) * DM + i]);
    for (size_t i = gt; i < (size_t)DECB * 3 * DM; i += NT) { const size_t b = i / (3 * DM), rem = i % (3 * DM); a.out[O_CS + i] = bf2f(XL[((size_t)SEQ + 4 * b + 1) * DM + rem]); }
    }
}

__device__ __forceinline__ void p3_carry(const Frame& F, const Args& a) {
    unsigned char* ws = a.ws;
    const unsigned* HA = (const unsigned*)(ws + WS_HLOC); const bf16_t* GL = (const bf16_t*)(ws + WS_GL); bf16_t* OAB = (bf16_t*)(ws + WS_OAB);
    const float* CARA = (const float*)(ws + WS_CARA); const float* CARH = (const float*)(ws + WS_CARH);
    for (int it = F.vcu; it < (SEQ / 128) * 4; it += F.G) {
        const int c = it >> 2, qd = it & 3, cg = F.tid & 127, rg = F.tid >> 7, ch0 = 1024 * qd + 8 * cg;
        float hin[8];
#pragma unroll
        for (int e = 0; e < 8; ++e) hin[e] = 0.f;
#pragma unroll 4
        for (int cc = 0; cc < c; ++cc) {
            const f32x4 a0 = *(const f32x4*)(CARA + (size_t)cc * DM + ch0), a1 = *(const f32x4*)(CARA + (size_t)cc * DM + ch0 + 4), h0 = *(const f32x4*)(CARH + (size_t)cc * DM + ch0), h1 = *(const f32x4*)(CARH + (size_t)cc * DM + ch0 + 4);
#pragma unroll
            for (int e = 0; e < 4; ++e) { hin[e] = a0[e] * hin[e] + h0[e]; hin[4 + e] = a1[e] * hin[4 + e] + h1[e]; }
        }
        if (c == SEQ / 128 - 1 && rg == 0) {
            const f32x4 a0 = *(const f32x4*)(CARA + (size_t)c * DM + ch0), a1 = *(const f32x4*)(CARA + (size_t)c * DM + ch0 + 4), h0 = *(const f32x4*)(CARH + (size_t)c * DM + ch0), h1 = *(const f32x4*)(CARH + (size_t)c * DM + ch0 + 4);
            f32x4 o0, o1;
#pragma unroll
            for (int e = 0; e < 4; ++e) { o0[e] = a0[e] * hin[e] + h0[e]; o1[e] = a1[e] * hin[4 + e] + h1[e]; }
            *(f32x4*)(a.out + O_HP + ch0) = o0; *(f32x4*)(a.out + O_HP + ch0 + 4) = o1;
        }
#pragma unroll 1
        for (int r4 = 0; r4 < 32; r4 += 4) {
            u32x4 p0[4], p1[4], gl[4];
#pragma unroll
            for (int k = 0; k < 4; ++k) { const size_t row = (size_t)c * 128 + rg * 32 + r4 + k;
                p0[k] = *(const u32x4*)(HA + row * DM + ch0); p1[k] = *(const u32x4*)(HA + row * DM + ch0 + 4); gl[k] = *(const u32x4*)(GL + row * DM + ch0); }
#pragma unroll
            for (int k = 0; k < 4; ++k) { const size_t row = (size_t)c * 128 + rg * 32 + r4 + k;
                u32x4 o;
                o.x = cvtpk((bfhi(p0[k].x) + bflo(p0[k].x) * hin[0]) * bflo(gl[k].x), (bfhi(p0[k].y) + bflo(p0[k].y) * hin[1]) * bfhi(gl[k].x));
                o.y = cvtpk((bfhi(p0[k].z) + bflo(p0[k].z) * hin[2]) * bflo(gl[k].y), (bfhi(p0[k].w) + bflo(p0[k].w) * hin[3]) * bfhi(gl[k].y));
                o.z = cvtpk((bfhi(p1[k].x) + bflo(p1[k].x) * hin[4]) * bflo(gl[k].z), (bfhi(p1[k].y) + bflo(p1[k].y) * hin[5]) * bfhi(gl[k].z));
                o.w = cvtpk((bfhi(p1[k].z) + bflo(p1[k].z) * hin[6]) * bflo(gl[k].w), (bfhi(p1[k].w) + bflo(p1[k].w) * hin[7]) * bfhi(gl[k].w));
                *(u32x4*)(OAB + row * KBR + ch0) = o; }
        }
    }
}

__device__ __forceinline__ void final_row(const Frame& F, const Args& a, int m, bool split) {
    unsigned char* ws = a.ws;
    const GAS f32x4* gp = (const GAS f32x4*)a.in[I_NPOST] + 2 * F.lane;
    const float* xrow = (m < SEQ) ? a.in[I_XP] + (size_t)m * DM : a.in[I_XS] + (size_t)(m - SEQ) * DM;
    const GAS f32x4* xr = (const GAS f32x4*)xrow + 2 * F.lane; const GAS u32x4* orow = (const GAS u32x4*)((const bf16_t*)(ws + WS_HLOC) + (size_t)m * DM) + F.lane;
    GAS f32x4* yr = (GAS f32x4*)(a.out + (size_t)m * DM) + 2 * F.lane;
    float o[8][8]; float s = 0.f;
#pragma unroll
    for (int j = 0; j < 8; ++j) { const u32x4 w = orow[64 * j];
        o[j][0] = bflo(w.x); o[j][1] = bfhi(w.x); o[j][2] = bflo(w.y); o[j][3] = bfhi(w.y); o[j][4] = bflo(w.z); o[j][5] = bfhi(w.z); o[j][6] = bflo(w.w); o[j][7] = bfhi(w.w); }
    if (split) { const GAS u32x4* o1 = (const GAS u32x4*)((const bf16_t*)(ws + WS_OF1) + (size_t)(m - SPL_PM0 * 256) * DM) + F.lane;
#pragma unroll
        for (int j = 0; j < 8; ++j) { const u32x4 w = o1[64 * j];
            o[j][0] += bflo(w.x); o[j][1] += bfhi(w.x); o[j][2] += bflo(w.y); o[j][3] += bfhi(w.y); o[j][4] += bflo(w.z); o[j][5] += bfhi(w.z); o[j][6] += bflo(w.w); o[j][7] += bfhi(w.w); } }
#pragma unroll
    for (int j = 0; j < 8; ++j)
#pragma unroll
        for (int e = 0; e < 8; ++e) s += o[j][e] * o[j][e];
    const float sc = 1.0f / sqrtf(wave_sum(s) * (1.0f / DM) + RMS_EPS);
    f32x4 xa[8][2], ga[8][2];
#pragma unroll
    for (int j = 0; j < 8; ++j) { xa[j][0] = xr[128 * j]; xa[j][1] = xr[128 * j + 1]; ga[j][0] = gp[128 * j]; ga[j][1] = gp[128 * j + 1]; }
#pragma unroll
    for (int j = 0; j < 8; ++j) { f32x4 y0, y1;
#pragma unroll
        for (int e = 0; e < 4; ++e) { y0[e] = xa[j][0][e] + o[j][e] * sc * ga[j][0][e]; y1[e] = xa[j][1][e] + o[j][4 + e] * sc * ga[j][1][e]; }
        yr[128 * j] = y0; yr[128 * j + 1] = y1; }
}
__device__ __forceinline__ void final_slices(const Frame& F, const Args& a, unsigned* ctl) {
    volatile LAS unsigned* bc = (volatile LAS unsigned*)(F.lds + MISC_OFF + 64);
    for (;;) {
        if (F.tid == 0) bc[0] = __hip_atomic_fetch_add(ctl + CW_FQ, 1u, __ATOMIC_RELAXED, __HIP_MEMORY_SCOPE_AGENT);
        __syncthreads();
        const unsigned idx = bc[0];
        if (idx >= (unsigned)(NPAN * 16)) break;
        const int q = (int)(idx >> 4), sl = (int)(idx & 15);
        const int pm = q;
        const bool split = (F.G == 256) && pm >= SPL_PM0 && pm < SPL_PM1;
        if (F.tid < 64) (void)panel_wait(ctl + CW_OD + 64 * pm, split ? 2 * NCT : NCT, ctl + CW_TMO);
        __syncthreads();
        final_row(F, a, pm * 256 + sl * 16 + F.wave * 2, split);
        final_row(F, a, pm * 256 + sl * 16 + F.wave * 2 + 1, split);
    }
}

__global__ void __launch_bounds__(NWAVES * 64, 2) hawk_fwd(Args args) {
    extern __shared__ __attribute__((aligned(16))) unsigned char lds[];
    Frame F;
    F.lds = (LAS unsigned char*)lds;
    F.tid = threadIdx.x; F.lane = F.tid & 63; F.wave = __builtin_amdgcn_readfirstlane(F.tid >> 6);
    F.G = gridDim.x; { const int bx = blockIdx.x; F.vcu = (F.G % 8 == 0) ? (bx % 8) * (F.G / 8) + bx / 8 : bx; }
    volatile LAS unsigned* MISC = (volatile LAS unsigned*)(F.lds + MISC_OFF);
    for (int u = F.tid; u < (LDS_BYTES - LDSCTL_OFF) / 4; u += NWAVES * 64) ((LAS unsigned*)(F.lds + LDSCTL_OFF))[u] = 0u;
    __syncthreads();
    unsigned* ctl = (unsigned*)(args.ws + WS_CTL);
    XcdBarrier bar; bar.bar = ctl + CW_BAR; bar.x = 0; bar.st = nullptr;
    if (N_LAUNCHES == 1) bar = xcd_barrier_post(ctl + CW_BAR, MISC + 8);
    const int lo = args.ph_lo, hi = args.ph_hi;
#define IN(k) (lo <= (k) && (k) < hi)
#define SEAM(k) do { if (N_LAUNCHES == 1 && IN(k) && IN((k) + 1)) xcd_barrier(bar); } while (0)
    unsigned char* ws = args.ws;

    if (IN(0)) REPS(0) { p0_prologue(F, args, ctl); SEAM(0); }
    { int t_ = threadIdx.x; asm volatile("" : "+v"(t_)); F.tid = t_; F.lane = t_ & 63; }
    if (IN(1)) REPS(1) {
        volatile LAS unsigned* bc = (volatile LAS unsigned*)(F.lds + MISC_OFF + 64);
        {
            const int nU = (MROWS / 256) * (GATE0 / 256 - NT8_SQ), rs = nU / F.G;
            EpiIn E{ws};
            SchedPlain S{(const char*)(ws + WS_XN), (const char*)(ws + WS_WIN), DM, DM, MROWS / 256, GATE0 / 256 - NT8_SQ, DM / 64, F.G, (int)blockIdx.x, rs, ctl + CW_Q1, bc, NT8_GL, NT8_S};
            gm::gemm_phase<true, false>(F.lds, DM, DM, S, E);
        }
        const int nUB = (MROWS / 256) * NT8, rsB = nUB / F.G, nDynB = nUB - rsB * F.G;
        {
            EpiGate E{ws};
            SchedPlain S{(const char*)(ws + WS_XN8), (const char*)(ws + WS_W8), DM / 2, DM / 2, MROWS / 256, NT8, DM / 128, F.G, (int)blockIdx.x, rsB, ctl + CW_Q3, bc, NT8, 0};
            gm::gemm_phase<true, true>(F.lds, DM / 2, DM / 2, S, E);
        }
        for (int idx = (int)bc[0];;) {
            __syncthreads();
            if (idx - nDynB >= SD_N) break;
            p0b_chunk(F, args, idx - nDynB);
            if (F.tid == 0) bc[0] = __hip_atomic_fetch_add(ctl + CW_Q3, 1u, __ATOMIC_RELAXED, __HIP_MEMORY_SCOPE_AGENT);
            __syncthreads();
            idx = (int)bc[0];
        }
        SEAM(1);
    }
    if (IN(2)) REPS(2) { p2_mixers(F, args); SEAM(2); }
    if (IN(4)) REPS(4) {
        const int v = tail_slot((int)blockIdx.x, F.G);
        {
            SchedBranch S{(const char*)(ws + WS_OAB), (const char*)(ws + WS_WBR), F.G, v};
            EpiBranch E{ws, ctl};
            gm::gemm_phase<true, false>(F.lds, KBR, KBR, S, E);
        }
        {
            SchedOut S{(const char*)(ws + WS_XN), (const char*)(ws + WS_WOUT), F.G, v, ctl};
            EpiOut E{ws, ctl};
            gm::gemm_phase<true, false>(F.lds, DM, DM, S, E);
        }
        final_slices(F, args, ctl);
    }
#undef IN
#undef SEAM
}

extern "C" void kernel_launch(void* const* d_in, const int* in_sizes, int n_in, void* d_out, int out_size, void* d_ws, size_t ws_size, hipStream_t stream) {
    static int grid = 0;
    if (grid == 0) {
        if (n_in != 19 || (size_t)out_size != O_END || ws_size < WS_END) { fprintf(stderr, "kernel_launch: unexpected shapes (n_in %d, out %d, ws %zu)\n", n_in, out_size, ws_size); grid = -1; return; }
        int dev = 0, cus = 0;
        if (hipGetDevice(&dev) != hipSuccess || hipDeviceGetAttribute(&cus, hipDeviceAttributeMultiprocessorCount, dev) != hipSuccess) { grid = -1; return; }
        if (hipFuncSetAttribute((const void*)hawk_fwd, hipFuncAttributeMaxDynamicSharedMemorySize, LDS_BYTES) != hipSuccess) { fprintf(stderr, "kernel_launch: hipFuncSetAttribute failed\n"); grid = -1; return; }
        grid = cus;
    }
    if (grid < 0) return;
    (void)hipMemsetAsync((char*)d_ws + WS_CTL, 0, CTL_ZERO_BYTES, stream);
    Args a{};
    for (int i = 0; i < 19; ++i) a.in[i] = (const float*)d_in[i];
    a.out = (float*)d_out; a.ws = (unsigned char*)d_ws;
    if (N_LAUNCHES == 1) { a.ph_lo = 0; a.ph_hi = N_PHASES; hipLaunchKernelGGL(hawk_fwd, dim3(grid), dim3(NWAVES * 64), LDS_BYTES, stream, a); }
    else for (int p = 0; p < N_PHASES; ++p) { a.ph_lo = p; a.ph_hi = p + 1; hipLaunchKernelGGL(hawk_fwd, dim3(grid), dim3(NWAVES * 64), LDS_BYTES, stream, a); }
}
```
